# Optimizing an MI355X kernel written in HIP

```python
import math
import jax, jax.numpy as jnp
from jax import lax
import numpy as np

D_MODEL = 1024
BATCH = 8
SEQ = 4096
DEPTH = 4

GLA_HEADS = 4
GLA_DK = 32
GLA_DV = 64
GLA_GATE_RANK = 16
GLA_TAU = 16.0
GLA_CHUNK = 64
DIFF_HEADS = 4
DIFF_D = 64
DIFF_QBLOCK = 128
RET_HEADS = 4
RET_DK = 64
RET_DV = 64
RET_CHUNK = 128
T5_BUCKETS = 32
T5_MAX_DIST = 128
N_EXPERTS = 32
TOP_K = 4
D_FF = D_MODEL
SWIGLU_LIMIT = 7.0
SWIGLU_ALPHA = 1.702
MOE_BLOCK = 256
PLE_DIM = 256
DEEPNORM_ALPHA = (2 * DEPTH) ** 0.25
DEEPNORM_BETA = (8 * DEPTH) ** -0.25
LN_EPS = 1e-5
HEAD_NORM_EPS = 1e-5

MIX_WIDTH = GLA_HEADS * GLA_DV + DIFF_HEADS * 2 * DIFF_D + RET_HEADS * RET_DV
IN_SPLITS = (GLA_HEADS * GLA_DK, GLA_HEADS * GLA_DK, GLA_HEADS * GLA_DV, GLA_GATE_RANK, GLA_HEADS * GLA_DV,
             DIFF_HEADS * 2 * DIFF_D, DIFF_HEADS * 2 * DIFF_D, DIFF_HEADS * 2 * DIFF_D,
             RET_HEADS * RET_DK, RET_HEADS * RET_DK, RET_HEADS * RET_DV, RET_HEADS * RET_DV)
IN_WIDTH = sum(IN_SPLITS)
IN_OFFSETS = tuple(int(o) for o in np.cumsum(IN_SPLITS)[:-1])

kernel_name = "hymba_gla_diff_retnet_moe_deepnorm"


def layer_norm(x, g, b):
    xf = x.astype(jnp.float32)
    mu = jnp.mean(xf, axis=-1, keepdims=True)
    var = jnp.mean(jnp.square(xf - mu), axis=-1, keepdims=True)
    y = (xf - mu) * lax.rsqrt(var + LN_EPS) * g.astype(jnp.float32) + b.astype(jnp.float32)
    return y.astype(x.dtype)


def head_rms_norm(x, g=None):
    xf = x.astype(jnp.float32)
    y = xf * lax.rsqrt(jnp.mean(jnp.square(xf), axis=-1, keepdims=True) + HEAD_NORM_EPS)
    if g is not None:
        y = y * g.astype(jnp.float32)
    return y


def to_chunks(t, c):
    b, s, h, d = t.shape
    return t.reshape(b, s // c, c, h, d).transpose(1, 0, 3, 2, 4)


def from_chunks(t):
    n, b, h, c, d = t.shape
    return t.transpose(1, 0, 3, 2, 4).reshape(b, n * c, h, d)


def t5_bucket(rel):
    n = jnp.maximum(-rel, 0)
    max_exact = T5_BUCKETS // 2
    nf = jnp.maximum(n, 1).astype(jnp.float32)
    large = max_exact + (jnp.log(nf / max_exact) / math.log(T5_MAX_DIST / max_exact)
                         * (T5_BUCKETS - max_exact)).astype(jnp.int32)
    large = jnp.minimum(large, T5_BUCKETS - 1)
    return jnp.where(n < max_exact, n, large)


def gla_group(q, k, v, gate_lr, out_gate, w_gate, b_gate, norm_g):
    b_, s_ = q.shape[:2]
    log_a = jax.nn.log_sigmoid((gate_lr @ w_gate + b_gate).astype(jnp.float32)) / GLA_TAU
    log_a = log_a.reshape(b_, s_, GLA_HEADS, GLA_DK)
    qc = to_chunks(q.astype(jnp.float32) * GLA_DK ** -0.5, GLA_CHUNK)
    kc = to_chunks(k.astype(jnp.float32), GLA_CHUNK)
    vc = to_chunks(v.astype(jnp.float32), GLA_CHUNK)
    lc = to_chunks(log_a, GLA_CHUNK)
    causal = jnp.tril(jnp.ones((GLA_CHUNK, GLA_CHUNK), dtype=bool))

    def step(state, inp):
        q_c, k_c, v_c, la_c = inp
        cum = jnp.cumsum(la_c, axis=2)
        diff = cum[:, :, :, None, :] - cum[:, :, None, :, :]
        decay = jnp.exp(jnp.where(causal[:, :, None], diff, -jnp.inf))
        scores = jnp.einsum('bhtc,bhsc,bhtsc->bhts', q_c, k_c, decay)
        o = scores @ v_c + jnp.einsum('bhtc,bhcv->bhtv', q_c * jnp.exp(cum), state)
        last = cum[:, :, -1:, :]
        state = jnp.exp(last[:, :, 0, :])[..., None] * state + \
            jnp.einsum('bhsc,bhsv->bhcv', k_c * jnp.exp(last - cum), v_c)
        return state, o

    s0 = jnp.zeros((b_, GLA_HEADS, GLA_DK, GLA_DV), jnp.float32)
    _, o = lax.scan(step, s0, (qc, kc, vc, lc))
    o = head_rms_norm(from_chunks(o), norm_g).reshape(b_, s_, GLA_HEADS * GLA_DV)
    return o * jax.nn.silu(out_gate.astype(jnp.float32))


def diff_group(q, k, v, lam, lam_init, norm_g, rel_bias):
    b_, s_ = q.shape[:2]
    nq = s_ // DIFF_QBLOCK
    qh = q.astype(jnp.float32).transpose(0, 2, 3, 1, 4) * DIFF_D ** -0.5
    kh = k.astype(jnp.float32).transpose(0, 2, 3, 1, 4)
    vh = v.astype(jnp.float32).transpose(0, 2, 1, 3)
    qb = qh.reshape(b_, DIFF_HEADS, 2, nq, DIFF_QBLOCK, DIFF_D).transpose(3, 0, 1, 2, 4, 5)
    kpos = jnp.arange(s_)

    def block(args):
        q_blk, blk = args
        qpos = blk * DIFF_QBLOCK + jnp.arange(DIFF_QBLOCK)
        rel = kpos[None, :] - qpos[:, None]
        bias = rel_bias[t5_bucket(rel)].astype(jnp.float32).transpose(2, 0, 1)
        logits = jnp.einsum('bhmqd,bhmkd->bhmqk', q_blk, kh) + bias[None, :, None]
        logits = jnp.where((rel <= 0)[None, None, None], logits, -jnp.inf)
        probs = jax.nn.softmax(logits, axis=-1)
        attn = probs[:, :, 0] - lam * probs[:, :, 1]
        return jnp.einsum('bhqk,bhke->bhqe', attn, vh)

    o = lax.map(block, (qb, jnp.arange(nq)))
    o = o.transpose(1, 0, 3, 2, 4).reshape(b_, s_, DIFF_HEADS, 2 * DIFF_D)
    o = head_rms_norm(o, norm_g) * (1.0 - lam_init)
    return o.reshape(b_, s_, DIFF_HEADS * 2 * DIFF_D)


def rotate_every_two(t):
    t1 = t[..., ::2]
    t2 = t[..., 1::2]
    return jnp.stack((-t2, t1), axis=-1).reshape(t.shape)


def retention_group(q, k, v, gate):
    b_, s_ = q.shape[:2]
    pos = jnp.arange(s_, dtype=jnp.float32)
    angle = 1.0 / (10000.0 ** jnp.linspace(0.0, 1.0, RET_DK // 2, dtype=jnp.float32))
    angle = jnp.repeat(angle, 2)
    sin = jnp.sin(pos[:, None] * angle)[None, :, None, :]
    cos = jnp.cos(pos[:, None] * angle)[None, :, None, :]
    qf = q.astype(jnp.float32)
    kf = k.astype(jnp.float32)
    qf = qf * cos + rotate_every_two(qf) * sin
    kf = (kf * cos + rotate_every_two(kf) * sin) * RET_DK ** -0.5
    log_g = jnp.log1p(-jnp.exp2(-5.0 - jnp.arange(RET_HEADS, dtype=jnp.float32)))
    idx = jnp.arange(RET_CHUNK, dtype=jnp.float32)
    rel = idx[:, None] - idx[None, :]
    inner_decay = jnp.where(rel[None] >= 0, jnp.exp(jnp.maximum(rel, 0.0)[None] * log_g[:, None, None]), 0.0)
    cross_decay = jnp.exp((idx + 1.0)[None] * log_g[:, None])
    state_decay = jnp.exp((RET_CHUNK - 1.0 - idx)[None] * log_g[:, None])
    chunk_decay = jnp.exp(RET_CHUNK * log_g)

    def step(state, inp):
        q_c, k_c, v_c = inp
        scores = jnp.einsum('bhtd,bhsd->bhts', q_c, k_c) * inner_decay
        o = scores @ v_c + jnp.einsum('bhtd,bhdv->bhtv', q_c, state) * cross_decay[:, :, None]
        state = state * chunk_decay[:, None, None] + \
            jnp.einsum('bhsd,bhsv->bhdv', k_c * state_decay[:, :, None], v_c)
        return state, o

    s0 = jnp.zeros((b_, RET_HEADS, RET_DK, RET_DV), jnp.float32)
    _, o = lax.scan(step, s0, (to_chunks(qf, RET_CHUNK), to_chunks(kf, RET_CHUNK),
                               to_chunks(v.astype(jnp.float32), RET_CHUNK)))
    o = head_rms_norm(from_chunks(o)).reshape(b_, s_, RET_HEADS * RET_DV)
    return o * jax.nn.silu(gate.astype(jnp.float32))


def hybrid_mixer(x, w_in, w_gla_gate, b_gla_gate, gla_norm_g, diff_lambda, diff_norm_g,
                 w_out, rel_bias, lam_init):
    b_, s_, _ = x.shape
    z = x @ w_in
    (gq, gk, gv, g_lr, g_out, dq, dk, dv, rq, rk, rv, rg) = jnp.split(z, IN_OFFSETS, axis=-1)
    gla_o = gla_group(gq.reshape(b_, s_, GLA_HEADS, GLA_DK), gk.reshape(b_, s_, GLA_HEADS, GLA_DK),
                      gv.reshape(b_, s_, GLA_HEADS, GLA_DV), g_lr, g_out,
                      w_gla_gate, b_gla_gate, gla_norm_g)
    lf = diff_lambda.astype(jnp.float32)
    lam = jnp.exp(jnp.sum(lf[0] * lf[1])) - jnp.exp(jnp.sum(lf[2] * lf[3])) + lam_init
    diff_o = diff_group(dq.reshape(b_, s_, DIFF_HEADS, 2, DIFF_D), dk.reshape(b_, s_, DIFF_HEADS, 2, DIFF_D),
                        dv.reshape(b_, s_, DIFF_HEADS, 2 * DIFF_D), lam, lam_init, diff_norm_g, rel_bias)
    ret_o = retention_group(rq.reshape(b_, s_, RET_HEADS, RET_DK), rk.reshape(b_, s_, RET_HEADS, RET_DK),
                            rv.reshape(b_, s_, RET_HEADS, RET_DV), rg)
    mixed = jnp.concatenate([gla_o, diff_o, ret_o], axis=-1).astype(x.dtype)
    return mixed @ w_out


def moe_ffn(h, w_router, b_router, w_gate_up, b_gate_up, w_down, b_down):
    n_tok, d = h.shape
    logits = (h @ w_router + b_router).astype(jnp.float32)
    top_v, top_i = lax.top_k(logits, TOP_K)
    gates = jax.nn.softmax(top_v, axis=-1)
    n_assign = n_tok * TOP_K
    e_flat = top_i.reshape(-1)
    tok_flat = jnp.repeat(jnp.arange(n_tok, dtype=jnp.int32), TOP_K)
    g_flat = gates.reshape(-1)
    order = jnp.argsort(e_flat)
    se, stok, sg = e_flat[order], tok_flat[order], g_flat[order]
    sizes = jnp.bincount(e_flat, length=N_EXPERTS)
    starts = jnp.cumsum(sizes) - sizes
    padded = ((sizes + MOE_BLOCK - 1) // MOE_BLOCK) * MOE_BLOCK
    pends = jnp.cumsum(padded)
    pstarts = pends - padded
    dest = pstarts[se] + (jnp.arange(n_assign) - starts[se])
    buf_len = ((n_assign + N_EXPERTS * (MOE_BLOCK - 1) + MOE_BLOCK - 1) // MOE_BLOCK) * MOE_BLOCK
    n_blk = buf_len // MOE_BLOCK
    buf_tok = jnp.full((buf_len,), n_tok, jnp.int32).at[dest].set(stok)
    buf_g = jnp.zeros((buf_len,), jnp.float32).at[dest].set(sg)
    blk_e = jnp.clip(jnp.searchsorted(pends, jnp.arange(n_blk) * MOE_BLOCK, side='right'), 0, N_EXPERTS - 1)
    h_pad = jnp.concatenate([h, jnp.zeros((1, d), h.dtype)], axis=0)

    def expert_block(args):
        tok, e = args
        hb = h_pad[tok]
        gu = hb @ w_gate_up[e] + b_gate_up[e]
        g = jnp.minimum(gu[:, ::2], SWIGLU_LIMIT)
        u = jnp.clip(gu[:, 1::2], -SWIGLU_LIMIT, SWIGLU_LIMIT)
        act = (u + 1.0) * (g * jax.nn.sigmoid(g * SWIGLU_ALPHA))
        return act @ w_down[e] + b_down[e]

    yb = lax.map(expert_block, (buf_tok.reshape(n_blk, MOE_BLOCK), blk_e))
    contrib = yb.reshape(buf_len, d).astype(jnp.float32) * buf_g[:, None]
    y = jax.ops.segment_sum(contrib, buf_tok, num_segments=n_tok + 1)[:n_tok]
    return y.astype(h.dtype)


def setup_inputs(seed: int = 0) -> dict:
    key = jax.random.key(seed)
    ks = jax.random.split(key, 24)
    f32 = jnp.float32

    def nrm(k, shape, scale):
        return jax.random.normal(k, shape, f32) * scale

    return {
        "x": nrm(ks[0], (BATCH, SEQ, D_MODEL), 1.0),
        "p": nrm(ks[1], (DEPTH, BATCH, SEQ, PLE_DIM), 1.0),
        "w_in": nrm(ks[2], (DEPTH, D_MODEL, IN_WIDTH), D_MODEL ** -0.5),
        "w_gla_gate": nrm(ks[3], (DEPTH, GLA_GATE_RANK, GLA_HEADS * GLA_DK), GLA_GATE_RANK ** -0.5),
        "b_gla_gate": nrm(ks[4], (DEPTH, GLA_HEADS * GLA_DK), 0.1),
        "gla_norm_g": 1.0 + nrm(ks[5], (DEPTH, GLA_DV), 0.02),
        "diff_lambda": nrm(ks[6], (DEPTH, 4, DIFF_D), 0.1),
        "diff_norm_g": 1.0 + nrm(ks[7], (DEPTH, 2 * DIFF_D), 0.02),
        "w_out": nrm(ks[8], (DEPTH, MIX_WIDTH, D_MODEL), MIX_WIDTH ** -0.5 * DEEPNORM_BETA),
        "rel_bias": nrm(ks[9], (T5_BUCKETS, DIFF_HEADS), 0.5),
        "ln1_g": 1.0 + nrm(ks[10], (DEPTH, D_MODEL), 0.02),
        "ln1_b": nrm(ks[11], (DEPTH, D_MODEL), 0.02),
        "w_router": nrm(ks[12], (DEPTH, D_MODEL, N_EXPERTS), D_MODEL ** -0.5),
        "b_router": nrm(ks[13], (DEPTH, N_EXPERTS), 0.01),
        "w_gate_up": nrm(ks[14], (DEPTH, N_EXPERTS, D_MODEL, 2 * D_FF), D_MODEL ** -0.5),
        "b_gate_up": nrm(ks[15], (DEPTH, N_EXPERTS, 2 * D_FF), 0.01),
        "w_down": nrm(ks[16], (DEPTH, N_EXPERTS, D_FF, D_MODEL), D_FF ** -0.5 * DEEPNORM_BETA),
        "b_down": nrm(ks[17], (DEPTH, N_EXPERTS, D_MODEL), 0.01),
        "w_ple_gate": nrm(ks[18], (DEPTH, D_MODEL, D_MODEL), D_MODEL ** -0.5),
        "b_ple_gate": nrm(ks[19], (DEPTH, D_MODEL), 0.01),
        "w_ple_proj": nrm(ks[20], (DEPTH, PLE_DIM, D_MODEL), PLE_DIM ** -0.5 * DEEPNORM_BETA),
        "ln2_g": 1.0 + nrm(ks[21], (DEPTH, D_MODEL), 0.02),
        "ln2_b": nrm(ks[22], (DEPTH, D_MODEL), 0.02),
    }


def reference(x, p, w_in, w_gla_gate, b_gla_gate, gla_norm_g, diff_lambda, diff_norm_g, w_out,
              rel_bias, ln1_g, ln1_b, w_router, b_router, w_gate_up, b_gate_up, w_down, b_down,
              w_ple_gate, b_ple_gate, w_ple_proj, ln2_g, ln2_b):
    b_, s_, d = x.shape
    for i in range(DEPTH):
        lam_init = 0.8 - 0.6 * math.exp(-0.3 * i)
        a = hybrid_mixer(x, w_in[i], w_gla_gate[i], b_gla_gate[i], gla_norm_g[i], diff_lambda[i],
                         diff_norm_g[i], w_out[i], rel_bias, lam_init)
        x = layer_norm(DEEPNORM_ALPHA * x + a, ln1_g[i], ln1_b[i])
        m = moe_ffn(x.reshape(b_ * s_, d), w_router[i], b_router[i], w_gate_up[i], b_gate_up[i],
                    w_down[i], b_down[i]).reshape(b_, s_, d)
        e = jax.nn.sigmoid(x @ w_ple_gate[i] + b_ple_gate[i]) * (p[i] @ w_ple_proj[i])
        x = layer_norm(DEEPNORM_ALPHA * x + m + e, ln2_g[i], ln2_b[i])
    return x
```

```cpp
#include <hip/hip_runtime.h>
#include <cstdio>
#include <cstdint>

#ifndef MK_SPLIT
#define MK_SPLIT 0
#endif

#define GAS __attribute__((address_space(1)))
#define LAS __attribute__((address_space(3)))
#define DI __device__ __forceinline__
typedef unsigned short bf16_t;
typedef short bf16x8 __attribute__((ext_vector_type(8)));
typedef short s16x4 __attribute__((ext_vector_type(4)));
typedef short v4i16_t __attribute__((ext_vector_type(4)));
typedef float f32x2 __attribute__((ext_vector_type(2)));
typedef float f32x4 __attribute__((ext_vector_type(4)));
typedef float f32x16 __attribute__((ext_vector_type(16)));
typedef unsigned u32x2 __attribute__((ext_vector_type(2)));
typedef unsigned u32x4 __attribute__((ext_vector_type(4)));
typedef __bf16 bf16x2_t __attribute__((ext_vector_type(2)));

constexpr int NB = 8, SEQ = 4096, DM = 1024, DEPTH = 4, NTOK = NB * SEQ;
constexpr int INW = 3344;
constexpr int ZW = 3584;
constexpr int ZC_GQ = 0, ZC_GK = 128, ZC_GV = 256, ZC_GO = 512, ZC_DQ = 768, ZC_DK = 1280, ZC_DV = 1792,
              ZC_RQ = 2304, ZC_RK = 2560, ZC_RV = 2816, ZC_RG = 3072, ZC_LR = 3328;
constexpr int NEXP = 32, TOPK = 4, DFF = 1024, PLE = 256;
constexpr int MAXSLOT = NTOK * TOPK + NEXP * 256;
constexpr float LN_EPS = 1e-5f, HN_EPS = 1e-5f;
constexpr float DN_ALPHA = 1.681792830507429f;
constexpr float LOG2E = 1.4426950408889634f;

__device__ const double kThetaRev[32] = {0.15915494309189535, 0.11824638530245714, 0.08785280158734302, 0.06527146455262238, 0.04849434517587465, 0.036029550281362475, 0.02676865702112893, 0.01988814717694384,
    0.01477617639986849, 0.010978166395165499, 0.008156381877047283, 0.0060598977032741905, 0.004502285538822983, 0.0033450358513712635, 0.0024852410515669447, 0.0018464445102618582,
    0.0013718417082023314, 0.0010192289353426582, 0.0007572503565305745, 0.0005626097166019918, 0.00041799873778229564, 0.0003105579936352166, 0.00023073339389116236, 0.00017142659389752471,
    0.00012736377946734852, 9.462669677672228e-05, 7.03042244845543e-05, 5.2233504378126876e-05, 3.8807610774786524e-05, 2.8832655820772147e-05, 2.14216238794896e-05, 1.5915494309189534e-05};

constexpr size_t MiB = 1u << 20;
constexpr size_t WS_CTL = 0, CTL_ZERO_BYTES = 1 * MiB;
constexpr size_t WS_SINCOS = 1 * MiB;
constexpr size_t WS_LIST = 2 * MiB;
constexpr size_t WS_ASG = 6 * MiB;
constexpr size_t WS_GATE = 7 * MiB;
constexpr size_t WS_WIN = 8 * MiB;
constexpr size_t WS_WOUT = 36 * MiB;
constexpr size_t WS_WPG = 44 * MiB;
constexpr size_t WS_WPP = 52 * MiB;
constexpr size_t WS_WGU = 64 * MiB;
constexpr size_t WS_WDN = 576 * MiB;
constexpr size_t WS_XB = 832 * MiB;
constexpr size_t WS_X1 = 896 * MiB;
constexpr size_t WS_X1B = 1024 * MiB;
constexpr size_t WS_Y1 = 1088 * MiB;
constexpr size_t WS_Z = 1216 * MiB;
constexpr size_t WS_MIX = 1440 * MiB;
constexpr size_t WS_PB = 1504 * MiB;
constexpr size_t WS_PP = 1568 * MiB;
constexpr size_t WS_EP = 1632 * MiB;
constexpr size_t WS_ACT = 1696 * MiB;
constexpr size_t WS_YB = 1968 * MiB;
constexpr size_t WS_GS = 2240 * MiB;
constexpr size_t GS_STRIDE = MiB + 65536;
constexpr size_t WS_END = WS_GS + 64 * GS_STRIDE;
static_assert(WS_ACT + (size_t)MAXSLOT * 1024 * 2 <= WS_YB && WS_YB + (size_t)MAXSLOT * 1024 * 2 <= WS_GS, "ws map");
constexpr int CW_BAR = 4096;
constexpr int CW_CNT = 8192;
constexpr int CW_Q = 8704;

constexpr int RING_BYTES = 131072;
constexpr int MISC_OFF = RING_BYTES;
constexpr int LDS_BYTES = 147456;
constexpr int MW_BAR = 8, MW_Q = 16, MW_PFX = 32, MW_CNT = 96;

DI unsigned pk2(float lo, float hi) { f32x2 v = {lo, hi}; bf16x2_t b = __builtin_convertvector(v, bf16x2_t); return __builtin_bit_cast(unsigned, b); }
DI float bflo(unsigned w) { return __uint_as_float(w << 16); }
DI float bfhi(unsigned w) { return __uint_as_float(w & 0xffff0000u); }
DI float bf2f(bf16_t h) { return __uint_as_float((unsigned)h << 16); }
DI bf16_t f2bf(float f) { return (bf16_t)(pk2(f, 0.f) & 0xffffu); }
DI int rfl(int v) { return __builtin_amdgcn_readfirstlane(v); }
template <class T> DI T* uni(T* p) { const unsigned long long v = (unsigned long long)p; const unsigned lo = (unsigned)__builtin_amdgcn_readfirstlane((int)(unsigned)v), hi = (unsigned)__builtin_amdgcn_readfirstlane((int)(unsigned)(v >> 32)); return (T*)(((unsigned long long)hi << 32) | lo); }
DI float unif(float v) { return __uint_as_float((unsigned)__builtin_amdgcn_readfirstlane((int)__float_as_uint(v))); }
#define NI __device__ __forceinline__
DI int opaque_tid() { int t = (int)threadIdx.x; asm volatile("" : "+v"(t)); return t; }
DI float wave_sum(float v) {
#pragma unroll
    for (int o = 1; o < 64; o <<= 1) v += __shfl_xor(v, o);
    return v;
}
DI float sigmoidf_(float x) { return __builtin_amdgcn_rcpf(1.f + __builtin_amdgcn_exp2f(-x * LOG2E)); }

namespace pg8 {
constexpr int BM = 256, BK = 64, HALF = 128, HTB = HALF * BK * 2, STAGE_BYTES = 8 * HTB, NXCD = 8, WGM = 8;
__host__ __device__ __forceinline__ int lds_byte(int r, int c) { const int st = (r >> 4) * 2 + (c >> 5), rr = r & 15, cc = c & 31, ob = rr * 64 + cc * 2; return st * 1024 + (ob ^ (((ob >> 9) & 1) << 5)); }
__host__ __device__ __forceinline__ void stage_rc(int b, int& R, int& C) { const int st = b / 1024, sb = b % 1024, swz = sb ^ (((sb >> 9) & 1) << 5); R = (st >> 1) * 16 + swz / 64; C = (st & 1) * 32 + (swz % 64) / 2; }
__host__ __device__ __forceinline__ int perm32(int rho) { const int n = rho >> 4, i = rho & 15; return 8 * (i >> 2) + 4 * n + (i & 3); }

struct Unit { int pm, pn, pb, e, r0, cnt; };

DI void order_map(int L, int nM, int nN, int nwg, int& pm, int& pn) {
    int wgid = L; { const int q = nwg / NXCD, r = nwg % NXCD, xcd = wgid % NXCD, off = wgid / NXCD; wgid = (xcd < r ? xcd * (q + 1) : r * (q + 1) + (xcd - r) * q) + off; }
    const int nig = WGM * nN, gid = wgid / nig, fm = gid * WGM, gsz = (nM - fm) < WGM ? (nM - fm) : WGM;
    pm = fm + ((wgid % nig) % gsz); pn = (wgid % nig) / gsz;
}
struct StaticOrder {
    int nM, nN, nwg, G, c;
    DI void init(int M, int N, int G_, int c_) { nM = M / BM; nN = N / BM; nwg = nM * nN; G = G_; c = c_; }
    DI bool next(int i, Unit& u) const {
        const long L = (long)i * G + c; if (L >= nwg) return false;
        order_map((int)L, nM, nN, nwg, u.pm, u.pn); u.pb = u.pn; u.e = 0; u.r0 = 0; u.cnt = 0; return true;
    }
};
struct MoeOrder {
    const LAS int* pfx; const LAS int* cnts; int nM, nN, nwg, G, c;
    DI void init(const LAS int* pfx_, const LAS int* cnts_, int nN_, int G_, int c_) { pfx = pfx_; cnts = cnts_; nM = rfl(pfx_[NEXP]); nN = nN_; nwg = nM * nN; G = G_; c = c_; }
    DI bool next(int i, Unit& u) const {
        const long L = (long)i * G + c; if (L >= nwg) return false;
        order_map((int)L, nM, nN, nwg, u.pm, u.pn);
        int e = 0;
#pragma unroll 1
        for (int j = 1; j < NEXP; ++j) { if (rfl(pfx[j]) <= u.pm) e = j; }
        u.e = e; u.pb = e * nN + u.pn; u.r0 = (u.pm - rfl(pfx[e])) * BM; u.cnt = rfl(cnts[e]); return true;
    }
};
struct NoGather { static constexpr bool ON = false; DI unsigned tok(const Unit&, int) const { return 0u; } };
struct MoeGather { static constexpr bool ON = true; const int* list;
    DI unsigned tok(const Unit& u, int row) const { const int p = u.r0 + row; return p < u.cnt ? (unsigned)list[(size_t)u.e * NTOK + p] : 0u; } };

struct EpiBf16 {
    static constexpr bool PERM = true;
    bf16_t* O; int ldc; const float* bias; int bias_estride;
    DI void operator()(const f32x4 (&acc)[2][2][4][2], const Unit& u, int wr, int wc, int fr, int fq) const {
        const int row0 = u.pm * BM + wr * 64 + fr; const int col0 = u.pn * BM + wc * 32 + 8 * fq;
        f32x4 bv[2][2];
#pragma unroll
        for (int bj = 0; bj < 2; ++bj)
#pragma unroll
            for (int n = 0; n < 2; ++n) bv[bj][n] = bias ? *(const f32x4*)(bias + (size_t)u.e * bias_estride + col0 + bj * HALF + 4 * n) : (f32x4){0.f, 0.f, 0.f, 0.f};
#pragma unroll
        for (int ai = 0; ai < 2; ++ai)
#pragma unroll
            for (int m = 0; m < 4; ++m) { bf16_t* rowp = O + (size_t)(row0 + ai * HALF + m * 16) * ldc + col0;
#pragma unroll
                for (int bj = 0; bj < 2; ++bj) { const f32x4 v0 = acc[ai][bj][m][0] + bv[bj][0], v1 = acc[ai][bj][m][1] + bv[bj][1];
                    u32x4 w; w.x = pk2(v0[0], v0[1]); w.y = pk2(v0[2], v0[3]); w.z = pk2(v1[0], v1[1]); w.w = pk2(v1[2], v1[3]);
                    *(u32x4*)(rowp + bj * HALF) = w; } }
    }
};
struct EpiResid {
    static constexpr bool PERM = false;
    const float* X; float* Y; float alpha;
    DI void operator()(const f32x4 (&acc)[2][2][4][2], const Unit& u, int wr, int wc, int fr, int fq) const {
        const int col0 = u.pn * BM + wc * 32 + 4 * fq;
#pragma unroll
        for (int ai = 0; ai < 2; ++ai)
#pragma unroll
            for (int m = 0; m < 4; ++m) { const size_t off = (size_t)(u.pm * BM + ai * HALF + wr * 64 + m * 16 + fr) * DM + col0;
#pragma unroll
                for (int bj = 0; bj < 2; ++bj)
#pragma unroll
                    for (int n = 0; n < 2; ++n) { const f32x4 xs = *(const f32x4*)(X + off + bj * HALF + n * 16); *(f32x4*)(Y + off + bj * HALF + n * 16) = xs * alpha + acc[ai][bj][m][n]; } }
    }
};
struct EpiSwiglu {
    static constexpr bool PERM = true;
    bf16_t* O; const float* bias;
    DI void operator()(const f32x4 (&acc)[2][2][4][2], const Unit& u, int wr, int wc, int fr, int fq) const {
        const int row0 = u.pm * BM + wr * 64 + fr; const int col0 = u.pn * BM + wc * 32 + 8 * fq;
        f32x4 bv[2][2];
#pragma unroll
        for (int bj = 0; bj < 2; ++bj)
#pragma unroll
            for (int n = 0; n < 2; ++n) bv[bj][n] = *(const f32x4*)(bias + (size_t)u.e * 2048 + col0 + bj * HALF + 4 * n);
#pragma unroll
        for (int ai = 0; ai < 2; ++ai)
#pragma unroll
            for (int m = 0; m < 4; ++m) { bf16_t* rowp = O + (size_t)(row0 + ai * HALF + m * 16) * DFF + (col0 >> 1);
#pragma unroll
                for (int bj = 0; bj < 2; ++bj) { const f32x4 v0 = acc[ai][bj][m][0] + bv[bj][0], v1 = acc[ai][bj][m][1] + bv[bj][1];
                    float a[4];
#pragma unroll
                    for (int k = 0; k < 4; ++k) { const float g = fminf(k < 2 ? v0[2 * k] : v1[2 * k - 4], 7.0f); const float uu = fminf(fmaxf(k < 2 ? v0[2 * k + 1] : v1[2 * k - 3], -7.0f), 7.0f);
                        a[k] = (uu + 1.0f) * (g * sigmoidf_(g * 1.702f)); }
                    u32x2 w; w.x = pk2(a[0], a[1]); w.y = pk2(a[2], a[3]);
                    *(u32x2*)(rowp + bj * (HALF / 2)) = w; } }
    }
};
struct EpiPle {
    static constexpr bool PERM = true;
    bf16_t* O; const bf16_t* PP; const float* bias;
    DI void operator()(const f32x4 (&acc)[2][2][4][2], const Unit& u, int wr, int wc, int fr, int fq) const {
        const int row0 = u.pm * BM + wr * 64 + fr; const int col0 = u.pn * BM + wc * 32 + 8 * fq;
        f32x4 bv[2][2];
#pragma unroll
        for (int bj = 0; bj < 2; ++bj)
#pragma unroll
            for (int n = 0; n < 2; ++n) bv[bj][n] = *(const f32x4*)(bias + col0 + bj * HALF + 4 * n);
#pragma unroll
        for (int ai = 0; ai < 2; ++ai)
#pragma unroll
            for (int m = 0; m < 4; ++m) { const size_t off = (size_t)(row0 + ai * HALF + m * 16) * DM + col0;
#pragma unroll
                for (int bj = 0; bj < 2; ++bj) { const f32x4 v0 = acc[ai][bj][m][0] + bv[bj][0], v1 = acc[ai][bj][m][1] + bv[bj][1];
                    const u32x4 pp = *(const u32x4*)(PP + off + bj * HALF);
                    u32x4 w; w.x = pk2(sigmoidf_(v0[0]) * bflo(pp.x), sigmoidf_(v0[1]) * bfhi(pp.x)); w.y = pk2(sigmoidf_(v0[2]) * bflo(pp.y), sigmoidf_(v0[3]) * bfhi(pp.y));
                    w.z = pk2(sigmoidf_(v1[0]) * bflo(pp.z), sigmoidf_(v1[1]) * bfhi(pp.z)); w.w = pk2(sigmoidf_(v1[2]) * bflo(pp.w), sigmoidf_(v1[3]) * bfhi(pp.w));
                    *(u32x4*)(O + off + bj * HALF) = w; } }
    }
};

template <class Epi, class Sched, class Gath, bool ALIGN_EPI>
DI void gemm_phase(LAS unsigned char* lds, const bf16_t* Abase, const bf16_t* Bbase, const int K, const Sched& S, const Epi& E, const Gath& G) {
    const int tid = opaque_tid(), wid = rfl(tid >> 6), lane = tid & 63, wr = wid >> 2, wc = wid & 3, fr = lane & 15, fq = lane >> 4;
    const int nt = K / BK;
    unsigned voffA[2], voffB[2], c2[2]; int Rr[2];
#pragma unroll
    for (int i = 0; i < 2; ++i) { int R, C; stage_rc(tid * 16 + i * 8192, R, C); const int Rb = Epi::PERM ? ((R & ~31) + perm32(R & 31)) : R;
        voffA[i] = (unsigned)(R * K + C) * 2u; voffB[i] = (unsigned)(Rb * K + C) * 2u; Rr[i] = R; c2[i] = (unsigned)C * 2u; }
    const size_t kstep = (size_t)(BK * 2);
    const size_t hstep = (size_t)HALF * K * 2;
    const size_t tstep = 2 * hstep;
    const unsigned ldsw = (unsigned)wid * 1024u;
    const int aoff = lds_byte(wr * 64 + fr, fq * 8), boff = lds_byte(wc * 32 + fr, fq * 8);
#define PG8_SA(b, h) (((b) * 2 + (h)) * HTB)
#define PG8_SB(b, h) ((4 + (b) * 2 + (h)) * HTB)
#define PG8_STAGE(bufoff, gbase, voff) do { _Pragma("unroll") for (int _i = 0; _i < 2; ++_i) \
        __builtin_amdgcn_global_load_lds((const unsigned*)((const char*)(gbase) + (voff)[_i]), (LAS unsigned*)(lds + (bufoff) + ldsw + _i * 8192), 16, 0, 0); } while (0)
#define PG8_STA(bufoff, kptr, h, VG) do { if constexpr (Gath::ON) { PG8_STAGE(bufoff, kptr, VG[h]); } else { PG8_STAGE(bufoff, (kptr) + (h) * hstep, voffA); } } while (0)
#define PG8_LDA(dst, b, h) do { _Pragma("unroll") for (int m = 0; m < 4; ++m) _Pragma("unroll") for (int k = 0; k < 2; ++k) dst[m][k] = *(const LAS bf16x8*)(lds + PG8_SA(b, h) + aoff + m * 2048 + k * 1024); } while (0)
#define PG8_LDB(dst, b, h) do { _Pragma("unroll") for (int n = 0; n < 2; ++n) _Pragma("unroll") for (int k = 0; k < 2; ++k) dst[n][k] = *(const LAS bf16x8*)(lds + PG8_SB(b, h) + boff + n * 2048 + k * 1024); } while (0)
#define PG8_MMA(ai, bj, At, Bt) do { __builtin_amdgcn_s_setprio(1); _Pragma("unroll") for (int m = 0; m < 4; ++m) _Pragma("unroll") for (int n = 0; n < 2; ++n) _Pragma("unroll") for (int k = 0; k < 2; ++k) \
        acc[ai][bj][m][n] = __builtin_amdgcn_mfma_f32_16x16x32_bf16(Bt[n][k], At[m][k], acc[ai][bj][m][n], 0, 0, 0); __builtin_amdgcn_s_setprio(0); } while (0)
#define PG8_WAIT_V(n) asm volatile("s_waitcnt vmcnt(" #n ")" ::: "memory")
#define PG8_WAIT_L(n) asm volatile("s_waitcnt lgkmcnt(" #n ")" ::: "memory")
#define PG8_BAR __builtin_amdgcn_s_barrier()
#define PG8_SCHED __builtin_amdgcn_sched_barrier(0)
    Unit cur, nxt; int ui = 0;
    if (!S.next(0, cur)) return;
    f32x4 acc[2][2][4][2];
#pragma unroll
    for (int a = 0; a < 2; ++a)
#pragma unroll
        for (int b = 0; b < 2; ++b)
#pragma unroll
            for (int m = 0; m < 4; ++m)
#pragma unroll
                for (int n = 0; n < 2; ++n) acc[a][b][m][n] = (f32x4){0.f, 0.f, 0.f, 0.f};
    bf16x8 At[4][2], B0[2][2], B1[2][2];
    unsigned vgC[2][2], vgN[2][2];
#pragma unroll
    for (int h = 0; h < 2; ++h)
#pragma unroll
        for (int i = 0; i < 2; ++i) { vgC[h][i] = Gath::ON ? G.tok(cur, h * HALF + Rr[i]) * (unsigned)(K * 2) + c2[i] : 0u; vgN[h][i] = vgC[h][i]; }
    const char* cA = Gath::ON ? (const char*)Abase : (const char*)Abase + (size_t)cur.pm * tstep; const char* cB = (const char*)Bbase + (size_t)cur.pb * tstep;
    PG8_STAGE(PG8_SB(0, 0), cB, voffB); PG8_STAGE(PG8_SB(0, 1), cB + hstep, voffB); PG8_STA(PG8_SA(0, 0), cA, 0, vgC); PG8_STA(PG8_SA(0, 1), cA, 1, vgC);
    if (wr == 1) PG8_BAR;
    PG8_WAIT_V(2); PG8_BAR;
    PG8_STAGE(PG8_SB(1, 0), cB + kstep, voffB); PG8_STA(PG8_SA(1, 0), cA + kstep, 0, vgC); PG8_STAGE(PG8_SB(1, 1), cB + hstep + kstep, voffB);
    PG8_WAIT_V(6); PG8_BAR;
    for (;;) {
        const bool has_next = S.next(ui + 1, nxt);
        const char* nA = has_next ? (Gath::ON ? (const char*)Abase : (const char*)Abase + (size_t)nxt.pm * tstep) : cA; const char* nB = has_next ? (const char*)Bbase + (size_t)nxt.pb * tstep : cB;
        if constexpr (Gath::ON) { if (has_next) {
#pragma unroll
            for (int h = 0; h < 2; ++h)
#pragma unroll
                for (int i = 0; i < 2; ++i) vgN[h][i] = G.tok(nxt, h * HALF + Rr[i]) * (unsigned)(K * 2) + c2[i]; } }
        for (int t = 0; t < nt; t += 2) {
            const bool last = (t == nt - 2);
            const char* a1 = cA + (size_t)(t + 1) * kstep;
            const char* a2 = last ? nA : cA + (size_t)(t + 2) * kstep; const char* b2 = last ? nB : cB + (size_t)(t + 2) * kstep;
            const char* a3 = a2 + kstep; const char* b3 = b2 + kstep;
            unsigned vs[2][2];
#pragma unroll
            for (int h = 0; h < 2; ++h)
#pragma unroll
                for (int i = 0; i < 2; ++i) vs[h][i] = last ? vgN[h][i] : vgC[h][i];
            PG8_LDB(B0, 0, 0); PG8_LDB(B1, 0, 1); PG8_SCHED; PG8_LDA(At, 0, 0); PG8_STA(PG8_SA(1, 1), a1, 1, vgC);
            PG8_WAIT_V(8); PG8_WAIT_L(0); PG8_BAR; PG8_MMA(0, 0, At, B0); PG8_MMA(0, 1, At, B1); PG8_BAR; PG8_SCHED;
            PG8_LDA(At, 0, 1); PG8_STAGE(PG8_SB(0, 0), b2, voffB); PG8_STAGE(PG8_SB(0, 1), b2 + hstep, voffB); PG8_STA(PG8_SA(0, 0), a2, 0, vs);
            PG8_WAIT_V(8); PG8_WAIT_L(0); PG8_BAR; PG8_MMA(1, 0, At, B0); PG8_MMA(1, 1, At, B1); PG8_BAR; PG8_SCHED;
            PG8_LDB(B0, 1, 0); PG8_LDB(B1, 1, 1); PG8_SCHED; PG8_LDA(At, 1, 0); PG8_STA(PG8_SA(0, 1), a2, 1, vs);
            PG8_WAIT_V(8); PG8_WAIT_L(0); PG8_BAR; PG8_MMA(0, 0, At, B0); PG8_MMA(0, 1, At, B1); PG8_BAR; PG8_SCHED;
            PG8_LDA(At, 1, 1); PG8_STAGE(PG8_SB(1, 0), b3, voffB); PG8_STAGE(PG8_SB(1, 1), b3 + hstep, voffB); PG8_STA(PG8_SA(1, 0), a3, 0, vs);
            PG8_WAIT_V(8); PG8_WAIT_L(0); PG8_BAR; PG8_MMA(1, 0, At, B0); PG8_MMA(1, 1, At, B1); PG8_BAR; PG8_SCHED;
        }
        if constexpr (ALIGN_EPI) { if (wr == 0) PG8_BAR; }
        E(acc, cur, wr, wc, fr, fq);
        if (!has_next) break;
#pragma unroll
        for (int a = 0; a < 2; ++a)
#pragma unroll
            for (int b = 0; b < 2; ++b)
#pragma unroll
                for (int m = 0; m < 4; ++m)
#pragma unroll
                    for (int n = 0; n < 2; ++n) acc[a][b][m][n] = (f32x4){0.f, 0.f, 0.f, 0.f};
        cur = nxt; cA = nA; cB = nB; ++ui;
#pragma unroll
        for (int h = 0; h < 2; ++h)
#pragma unroll
            for (int i = 0; i < 2; ++i) vgC[h][i] = vgN[h][i];
        if constexpr (ALIGN_EPI) { if (wr == 1) PG8_BAR; }
    }
    PG8_WAIT_V(0);
    if constexpr (!ALIGN_EPI) { if (wr == 0) PG8_BAR; }
    PG8_BAR;
#undef PG8_SA
#undef PG8_SB
#undef PG8_STAGE
#undef PG8_STA
#undef PG8_LDA
#undef PG8_LDB
#undef PG8_MMA
#undef PG8_WAIT_V
#undef PG8_WAIT_L
#undef PG8_BAR
#undef PG8_SCHED
}
}

typedef GAS unsigned gu32;
#define RLX_AGENT __ATOMIC_RELAXED, __HIP_MEMORY_SCOPE_AGENT
#define XB_TMO      128
#define XB_XCNT(j)  (256  + 64 * (j))
#define XB_XSUB(j)  (1280 + 64 * (j))
#define XB_XGEN(j)  (2304 + 64 * (j))
#define XB_TOP      3328
#define XB_TOPGEN   3392
#define XCD_BAR_WORDS 3456
#define XB_SPIN_CAP (1u << 18)
DI unsigned xb_ld(unsigned* p)              { return __hip_atomic_load(p, __ATOMIC_RELAXED, __HIP_MEMORY_SCOPE_AGENT); }
DI unsigned xb_add(unsigned* p, unsigned v) { return __hip_atomic_fetch_add(p, v, __ATOMIC_RELAXED, __HIP_MEMORY_SCOPE_AGENT); }
DI unsigned xb_xcc_id() { return (unsigned)__builtin_amdgcn_s_getreg((3 << 11) | 20) & 0xFu; }
#define XB_SPIN(cond, bar) do { unsigned _sp = 0; while (cond) { __builtin_amdgcn_s_sleep(1); \
    if ((++_sp & 255u) == 0u) { if (xb_ld(&(bar)[XB_TMO])) break; if (_sp > XB_SPIN_CAP) { atomicAdd(&(bar)[XB_TMO], 1u); break; } } } } while (0)
struct XcdBarrier { unsigned* bar; unsigned x; volatile LAS unsigned* st; };
DI XcdBarrier xcd_barrier_post(unsigned* bar, volatile LAS unsigned* st) {
    XcdBarrier b; b.bar = bar; b.x = xb_xcc_id(); b.st = st;
    if (threadIdx.x == 0) (void)xb_add(&bar[XB_XCNT(b.x)], 1u);
    return b;
}
DI void xcd_barrier_complete(unsigned* bar, unsigned x, unsigned& nloc, unsigned& nx) {
    const unsigned G = gridDim.x * gridDim.y * gridDim.z;
    unsigned sum, cnt, mine, sp = 0u;
    for (;;) {
        sum = 0u; cnt = 0u; mine = 0u;
#pragma unroll
        for (unsigned j = 0; j < 16; ++j) { const unsigned c = xb_ld(&bar[XB_XCNT(j)]); sum += c; cnt += (c > 0u) ? 1u : 0u; mine = (j == x) ? c : mine; }
        if (sum == G) break;
        __builtin_amdgcn_s_sleep(1);
        if ((++sp & 255u) == 0u) { if (xb_ld(&bar[XB_TMO])) break; if (sp > XB_SPIN_CAP) { atomicAdd(&bar[XB_TMO], 1u); break; } }
    }
    nloc = mine > 0u ? mine : 1u; nx = cnt > 0u ? cnt : 1u;
}
DI void xcd_barrier(const XcdBarrier& b) {
    asm volatile("s_waitcnt vmcnt(0)" ::: "memory");
    __syncthreads();
    if (threadIdx.x == 0) {
        unsigned* bar = b.bar;
        __builtin_amdgcn_s_waitcnt(0);
        unsigned nloc = b.st[0], nx = b.st[1];
        if (nloc == 0u) { xcd_barrier_complete(bar, b.x, nloc, nx); b.st[0] = nloc; b.st[1] = nx; }
        const unsigned old = xb_add(&bar[XB_XSUB(b.x)], 1u);
        const unsigned gen = old / nloc;
        if (old + 1u == (gen + 1u) * nloc) {
            __builtin_amdgcn_fence(__ATOMIC_RELEASE, "agent");
            asm volatile("s_waitcnt vmcnt(0)" ::: "memory");
            const unsigned og = xb_add(&bar[XB_TOP], 1u);
            const unsigned tg = og / nx;
            if (og + 1u == (tg + 1u) * nx) xb_add(&bar[XB_TOPGEN], 1u);
            else XB_SPIN(xb_ld(&bar[XB_TOPGEN]) == tg, bar);
            __builtin_amdgcn_fence(__ATOMIC_ACQUIRE, "agent");
            xb_add(&bar[XB_XGEN(b.x)], 1u);
            asm volatile("s_waitcnt vmcnt(0)" ::: "memory");
        } else {
            XB_SPIN(xb_ld(&bar[XB_XGEN(b.x)]) == gen, bar);
            __builtin_amdgcn_fence(__ATOMIC_ACQUIRE, "agent");
            asm volatile("s_waitcnt vmcnt(0)" ::: "memory");
        }
    }
    __syncthreads();
}

struct Args {
    const float* in[23]; float* out; unsigned char* ws; int ph_lo, ph_hi;
};
struct Ctx {
    LAS unsigned char* lds; volatile LAS unsigned* MISC; unsigned* ctl; unsigned char* ws;
    int tid, lane, wave, G, blk;
};
DI Ctx make_ctx(LAS unsigned char* lds, unsigned char* ws, int G, int blk) {
    Ctx X; X.lds = lds; X.MISC = (volatile LAS unsigned*)(lds + 131072); X.ws = ws; X.ctl = (unsigned*)ws;
    X.tid = opaque_tid(); X.lane = X.tid & 63; X.wave = __builtin_amdgcn_readfirstlane(X.tid >> 6); X.G = G; X.blk = blk; return X;
}

#define MFMA32(a, b, c) __builtin_amdgcn_mfma_f32_32x32x16_bf16((a), (b), (c), 0, 0, 0)
DI int crow(int reg, int h) { return (reg & 3) + 8 * (reg >> 2) + 4 * h; }
DI s16x4 tr16(const LAS unsigned char* p) { return __builtin_bit_cast(s16x4, __builtin_amdgcn_ds_read_tr16_b64_v4i16((LAS v4i16_t*)p)); }
DI bf16x8 frag_tr(const LAS unsigned char* img, int pitch, int k_lo, int k_hi, int m0, int lane) {
    const int i16 = lane & 15, q = i16 >> 2, p = i16 & 3, blk = (lane >> 4) & 1;
    const LAS unsigned char* a = img + (m0 + 16 * blk + 4 * p) * 2;
    const s16x4 lo = tr16(a + (k_lo + q) * pitch), hi = tr16(a + (k_hi + q) * pitch);
    return __builtin_shufflevector(lo, hi, 0, 1, 2, 3, 4, 5, 6, 7);
}
DI bf16x8 frag_row(const LAS unsigned char* img, int pitch, int row, int kbyte) { return *(const LAS bf16x8*)(img + row * pitch + kbyte); }
template <int s> DI bf16x8 pack8(const f32x16& x) {
    u32x4 p; p.x = pk2(x[8 * s], x[8 * s + 1]); p.y = pk2(x[8 * s + 2], x[8 * s + 3]); p.z = pk2(x[8 * s + 4], x[8 * s + 5]); p.w = pk2(x[8 * s + 6], x[8 * s + 7]);
    return __builtin_bit_cast(bf16x8, p);
}
DI f32x16 zero16() { f32x16 z;
#pragma unroll
    for (int i = 0; i < 16; ++i) z[i] = 0.f;
    return z; }
DI f32x16 splat16(float v) { f32x16 z;
#pragma unroll
    for (int i = 0; i < 16; ++i) z[i] = v;
    return z; }

DI void transpose_item(const float* W, int K, int srcN, bf16_t* WT, int k0, int n0dst, int scol, int nvalid, LAS float* scr, int lane) {
    const int cl = lane & 31; const bool ok = cl < nvalid;
#pragma unroll 8
    for (int i = 0; i < 32; ++i) { const int kk = 2 * i + (lane >> 5); scr[kk * 33 + cl] = ok ? W[(size_t)(k0 + kk) * srcN + scol + cl] : 0.f; }
    asm volatile("s_waitcnt lgkmcnt(0)" ::: "memory");
    const int c = lane & 7;
#pragma unroll
    for (int j = 0; j < 4; ++j) { const int n = (lane >> 3) + 8 * j; const LAS float* s = scr + (8 * c) * 33 + n;
        u32x4 o; o.x = pk2(s[0 * 33], s[1 * 33]); o.y = pk2(s[2 * 33], s[3 * 33]); o.z = pk2(s[4 * 33], s[5 * 33]); o.w = pk2(s[6 * 33], s[7 * 33]);
        *(u32x4*)(WT + (size_t)(n0dst + n) * K + k0 + 8 * c) = o; }
    asm volatile("s_waitcnt lgkmcnt(0)" ::: "memory");
}
DI void transpose_batch(Ctx& X, const float* W, bf16_t* WT, int nmat, int K, int N, int gw, int NGW, LAS float* scr) {
    const int nb = N / 32, per = (K / 64) * nb; const long total = (long)nmat * per;
    for (long it = gw; it < total; it += NGW) { const int mat = (int)(it / per), r = (int)(it % per), kb = r / nb, nbk = r % nb;
        transpose_item(W + (size_t)mat * K * N, K, N, WT + (size_t)mat * K * N, 64 * kb, 32 * nbk, 32 * nbk, 32, scr, X.lane); }
}
NI void ph_p0(LAS unsigned char* lds_, unsigned char* ws_, const float* x_, const float* p_, const float* w_in_, const float* w_out_, const float* w_gu_, const float* w_dn_, const float* w_pg_, const float* w_pp_, int G_, int blk_) {
    Ctx X = make_ctx(lds_, uni(ws_), rfl(G_), rfl(blk_));
    const float* const in0 = uni(x_); const float* const in1 = uni(p_); const float* const in2 = uni(w_in_); const float* const in8 = uni(w_out_);
    const float* const in14 = uni(w_gu_); const float* const in16 = uni(w_dn_); const float* const in18 = uni(w_pg_); const float* const in20 = uni(w_pp_);
    LAS float* scr = (LAS float*)(X.lds + X.wave * 16384);
    const int gw = X.blk * 8 + X.wave, NGW = X.G * 8;
    unsigned char* ws = X.ws;
    { const int nb = ZW / 32, per = 16 * nb; const long total = (long)DEPTH * per;
      for (long it = gw; it < total; it += NGW) { const int mat = (int)(it / per), r = (int)(it % per), kb = r / nb, nbk = r % nb, n0 = 32 * nbk;
          int scol, nv; if (n0 < 512) { scol = n0; nv = 32; } else if (n0 < 3328) { scol = n0 + 16; nv = 32; } else if (n0 == 3328) { scol = 512; nv = 16; } else { scol = 0; nv = 0; }
          transpose_item(in2 + (size_t)mat * DM * INW, DM, INW, (bf16_t*)(ws + WS_WIN) + (size_t)mat * ZW * DM, 64 * kb, n0, scol, nv, scr, X.lane); } }
    transpose_batch(X, in8, (bf16_t*)(ws + WS_WOUT), DEPTH, DM, DM, gw, NGW, scr);
    transpose_batch(X, in18, (bf16_t*)(ws + WS_WPG), DEPTH, DM, DM, gw, NGW, scr);
    transpose_batch(X, in20, (bf16_t*)(ws + WS_WPP), DEPTH, PLE, DM, gw, NGW, scr);
    transpose_batch(X, in14, (bf16_t*)(ws + WS_WGU), DEPTH * NEXP, DM, 2 * DFF, gw, NGW, scr);
    transpose_batch(X, in16, (bf16_t*)(ws + WS_WDN), DEPTH * NEXP, DFF, DM, gw, NGW, scr);
    const long gt = (long)X.blk * 512 + X.tid, NGT = (long)X.G * 512;
    { const f32x4* src = (const f32x4*)in0; u32x4* dst = (u32x4*)(ws + WS_XB);
      for (long i = gt; i < (long)NTOK * DM / 8; i += NGT) { const f32x4 a = src[2 * i], b = src[2 * i + 1]; u32x4 o; o.x = pk2(a[0], a[1]); o.y = pk2(a[2], a[3]); o.z = pk2(b[0], b[1]); o.w = pk2(b[2], b[3]); dst[i] = o; } }
    { const f32x4* src = (const f32x4*)in1; u32x4* dst = (u32x4*)(ws + WS_PB);
      for (long i = gt; i < (long)DEPTH * NTOK * PLE / 8; i += NGT) { const f32x4 a = src[2 * i], b = src[2 * i + 1]; u32x4 o; o.x = pk2(a[0], a[1]); o.y = pk2(a[2], a[3]); o.z = pk2(b[0], b[1]); o.w = pk2(b[2], b[3]); dst[i] = o; } }
    { f32x2* sc = (f32x2*)(ws + WS_SINCOS);
      for (long i = gt; i < (long)SEQ * 32; i += NGT) { const int t = (int)(i >> 5), j = (int)(i & 31); const double rev = (double)t * kThetaRev[j]; const float fr = (float)(rev - __builtin_floor(rev));
          sc[i] = (f32x2){__builtin_amdgcn_sinf(fr), __builtin_amdgcn_cosf(fr)}; } }
}

constexpr int AT_KP = 272, AT_VP = 320, AT_KB = 64 * AT_KP, AT_VB = 64 * AT_VP;
constexpr int AT_BIAS_OFF = 122880;
NI void attn_unit(LAS unsigned char* lds, const bf16_t* z_, bf16_t* mixed_, int b_, int h_, int qb_, float lam_, float outscale_, const float* normg_) {
    const bf16_t* const z = uni(z_); bf16_t* const mixed = uni(mixed_); const int b = rfl(b_), h = rfl(h_), qb = rfl(qb_); const float lam = unif(lam_), outscale = unif(outscale_); const float* const normg = uni(normg_);
    const int tid = opaque_tid(), lane = tid & 63, w = rfl(tid >> 6), r = lane & 31, hh = lane >> 5;
    const int map = w & 1, qsub = w >> 1;
    const int q0 = qb * 128;
    const size_t rowbase = (size_t)b * SEQ;
    const int NT = (q0 + 128) / 64;
    const LAS float* biasT = (const LAS float*)(lds + AT_BIAS_OFF) + h * 128;
    const int qpos = q0 + 32 * qsub + r;
    const float C2 = 0.125f * LOG2E;
    bf16x8 qf[4];
    { const bf16_t* qrow = z + (rowbase + qpos) * ZW + ZC_DQ + h * 128 + map * 64 + 8 * hh;
#pragma unroll
      for (int ds = 0; ds < 4; ++ds) { u32x4 raw = *(const u32x4*)(qrow + 16 * ds);
          raw.x = pk2(bflo(raw.x) * C2, bfhi(raw.x) * C2); raw.y = pk2(bflo(raw.y) * C2, bfhi(raw.y) * C2); raw.z = pk2(bflo(raw.z) * C2, bfhi(raw.z) * C2); raw.w = pk2(bflo(raw.w) * C2, bfhi(raw.w) * C2);
          qf[ds] = __builtin_bit_cast(bf16x8, raw); } }
    const bf16_t* kg = z + (rowbase + (tid >> 4)) * ZW + ZC_DK + h * 128 + (tid & 15) * 8;
    const bf16_t* vg = z + (rowbase + (tid >> 4)) * ZW + ZC_DV + h * 128 + (tid & 15) * 8;
    const int kdst = (tid >> 4) * AT_KP + (tid & 15) * 16, vdst = 2 * AT_KB + (tid >> 4) * AT_VP + (tid & 15) * 16;
    u32x4 kr0, kr1, vr0, vr1;
    kr0 = *(const u32x4*)(kg); kr1 = *(const u32x4*)(kg + (size_t)32 * ZW); vr0 = *(const u32x4*)(vg); vr1 = *(const u32x4*)(vg + (size_t)32 * ZW);
    *(LAS u32x4*)(lds + kdst) = kr0; *(LAS u32x4*)(lds + kdst + 32 * AT_KP) = kr1; *(LAS u32x4*)(lds + vdst) = vr0; *(LAS u32x4*)(lds + vdst + 32 * AT_VP) = vr1;
    __syncthreads();
    f32x16 O[4];
#pragma unroll
    for (int et = 0; et < 4; ++et) O[et] = zero16();
    float m_run = -1e30f, l_run = 0.f;
    const float bias_far = biasT[127];
    for (int t = 0; t < NT; ++t) {
        const bool more = (t + 1 < NT);
        if (more) { const size_t go = (size_t)(t + 1) * 64 * ZW; kr0 = *(const u32x4*)(kg + go); kr1 = *(const u32x4*)(kg + go + (size_t)32 * ZW); vr0 = *(const u32x4*)(vg + go); vr1 = *(const u32x4*)(vg + go + (size_t)32 * ZW); }
        const bool active = (64 * t <= q0 + 32 * qsub + 31);
        if (active) {
            const LAS unsigned char* Kb = lds + (t & 1) * AT_KB; const LAS unsigned char* Vb = lds + 2 * AT_KB + (t & 1) * AT_VB;
            const bool near = (t >= NT - 4);
            f32x16 p0 = splat16(near ? 0.f : bias_far), p1 = p0;
#pragma unroll
            for (int ds = 0; ds < 4; ++ds) { const int kbyte = (map * 64 + 16 * ds + 8 * hh) * 2;
                const bf16x8 a0 = frag_row(Kb, AT_KP, r, kbyte), a1 = frag_row(Kb, AT_KP, 32 + r, kbyte);
                p0 = MFMA32(a0, qf[ds], p0); p1 = MFMA32(a1, qf[ds], p1); }
            if (near) {
#pragma unroll
                for (int reg = 0; reg < 16; ++reg) { const int n0 = qpos - (64 * t + crow(reg, hh)), n1 = n0 - 32;
                    p0[reg] = n0 < 0 ? -1e30f : p0[reg] + biasT[n0 > 127 ? 127 : (n0 < 0 ? 0 : n0)];
                    p1[reg] = n1 < 0 ? -1e30f : p1[reg] + biasT[n1 > 127 ? 127 : (n1 < 0 ? 0 : n1)]; }
            }
            float mx = fmaxf(p0[0], p1[0]);
#pragma unroll
            for (int reg = 1; reg < 16; ++reg) mx = fmaxf(mx, fmaxf(p0[reg], p1[reg]));
            mx = fmaxf(mx, __shfl_xor(mx, 32));
            const float m_new = fmaxf(m_run, mx); const float alpha = __builtin_amdgcn_exp2f(m_run - m_new); m_run = m_new;
            float ps = 0.f;
#pragma unroll
            for (int reg = 0; reg < 16; ++reg) { p0[reg] = __builtin_amdgcn_exp2f(p0[reg] - m_new); p1[reg] = __builtin_amdgcn_exp2f(p1[reg] - m_new); ps += p0[reg] + p1[reg]; }
            l_run = l_run * alpha + ps;
#pragma unroll
            for (int et = 0; et < 4; ++et) O[et] = O[et] * alpha;
            const bf16x8 pb00 = pack8<0>(p0), pb01 = pack8<1>(p0), pb10 = pack8<0>(p1), pb11 = pack8<1>(p1);
#pragma unroll
            for (int et = 0; et < 4; ++et) {
                O[et] = MFMA32(frag_tr(Vb, AT_VP, 0 + 4 * hh, 8 + 4 * hh, 32 * et, lane), pb00, O[et]);
                O[et] = MFMA32(frag_tr(Vb, AT_VP, 16 + 4 * hh, 24 + 4 * hh, 32 * et, lane), pb01, O[et]);
                O[et] = MFMA32(frag_tr(Vb, AT_VP, 32 + 4 * hh, 40 + 4 * hh, 32 * et, lane), pb10, O[et]);
                O[et] = MFMA32(frag_tr(Vb, AT_VP, 48 + 4 * hh, 56 + 4 * hh, 32 * et, lane), pb11, O[et]);
            }
        }
        if (more) { const int bo = ((t + 1) & 1); *(LAS u32x4*)(lds + bo * AT_KB + kdst) = kr0; *(LAS u32x4*)(lds + bo * AT_KB + kdst + 32 * AT_KP) = kr1;
            *(LAS u32x4*)(lds + bo * AT_VB + vdst) = vr0; *(LAS u32x4*)(lds + bo * AT_VB + vdst + 32 * AT_VP) = vr1; }
        __syncthreads();
    }
    const float l_tot = l_run + __shfl_xor(l_run, 32); const float inv = 1.0f / l_tot;
    LAS float* xch = (LAS float*)lds + qsub * 4096;
    if (map == 1) { const float sc = inv * lam;
#pragma unroll
        for (int et = 0; et < 4; ++et)
#pragma unroll
            for (int reg = 0; reg < 16; ++reg) xch[(et * 16 + reg) * 64 + lane] = O[et][reg] * sc; }
    __syncthreads();
    if (map == 0) { float ss = 0.f;
#pragma unroll
        for (int et = 0; et < 4; ++et)
#pragma unroll
            for (int reg = 0; reg < 16; ++reg) { const float d = O[et][reg] * inv - xch[(et * 16 + reg) * 64 + lane]; O[et][reg] = d; ss += d * d; }
        ss += __shfl_xor(ss, 32);
        const float rn = __builtin_amdgcn_rsqf(ss * (1.0f / 128.0f) + HN_EPS) * outscale;
        bf16_t* orow = mixed + (rowbase + qpos) * DM + 256 + h * 128;
#pragma unroll
        for (int et = 0; et < 4; ++et)
#pragma unroll
            for (int rg = 0; rg < 4; ++rg) { const int e0 = 32 * et + 8 * rg + 4 * hh; const f32x4 g4 = *(const f32x4*)(normg + e0);
                u32x2 o; o.x = pk2(O[et][4 * rg] * rn * g4[0], O[et][4 * rg + 1] * rn * g4[1]); o.y = pk2(O[et][4 * rg + 2] * rn * g4[2], O[et][4 * rg + 3] * rn * g4[3]);
                *(u32x2*)(orow + e0) = o; } }
    __syncthreads();
}

template <int C, int DK, bool GLA>
NI void stream_run(LAS unsigned char* lds, unsigned char* ws_, const float* wg_, const float* bg_, const float* ngain_, int sidx_, int b_, int h_) {
    unsigned char* const ws = uni(ws_); const float* const wgL = uni(wg_); const float* const bgL = uni(bg_); const float* const ngain = uni(ngain_); const int sidx = rfl(sidx_), b = rfl(b_), h = rfl(h_);
    constexpr int PQ = DK * 2 + 16, PV = 192, NC = SEQ / C;
    constexpr int OFF_Q = 0, OFF_K = C * PQ, OFF_V = 2 * C * PQ, OFF_ST = 2 * C * PQ + C * PV, ST_BYTES = 64 * PQ;
    constexpr int NQ = C * DK / 8;
    constexpr int NQK = (2 * NQ) / 512 > 0 ? (2 * NQ) / 512 : 1, NVP = (C * 8) / 512;
    constexpr int NTT = C / 32, NKS = DK / 16;
    const int tid = opaque_tid(), lane = tid & 63, w = rfl(tid >> 6), r = lane & 31, hh = lane >> 5;
    const size_t rowbase = (size_t)b * SEQ;
    const bf16_t* z = (const bf16_t*)(ws + WS_Z);
    bf16_t* mixed = (bf16_t*)(ws + WS_MIX);
    unsigned char* gs = ws + WS_GS + (size_t)sidx * GS_STRIDE;
    bf16_t* QP = (bf16_t*)gs; bf16_t* KP = (bf16_t*)(gs + 512 * 1024); float* DG = (float*)(gs + MiB);
    const int zq = GLA ? ZC_GQ + h * 32 : ZC_RQ + h * 64, zk = GLA ? ZC_GK + h * 32 : ZC_RK + h * 64, zv = GLA ? ZC_GV + h * 64 : ZC_RV + h * 64, zg = GLA ? ZC_GO + h * 64 : ZC_RG + h * 64;
    const int mcol = GLA ? h * 64 : 768 + h * 64;
    const float l2g_tab[4] = {-0.04580368961312479f, -0.02272007650008353f, -0.011315313227834146f, -0.005646563141142063f};
    const float log2g = h == 0 ? l2g_tab[0] : h == 1 ? l2g_tab[1] : h == 2 ? l2g_tab[2] : l2g_tab[3];
    if constexpr (GLA) {
        const float* wg = wgL + h * 32; const float* bg = bgL + h * 32;
        for (int pair = tid; pair < NC * 32; pair += 512) { const int chunk = pair >> 5, c = pair & 31;
            float wcol[16];
#pragma unroll
            for (int rr = 0; rr < 16; ++rr) wcol[rr] = wg[rr * 128 + c];
            const float bb = bg[c]; float cum = 0.f;
            for (int t = 0; t < C; ++t) { const size_t row = rowbase + (size_t)chunk * C + t; const bf16_t* zr = z + row * ZW;
                const u32x4 g0 = *(const u32x4*)(zr + ZC_LR), g1 = *(const u32x4*)(zr + ZC_LR + 8);
                float x = bb;
                x += bflo(g0.x) * wcol[0] + bfhi(g0.x) * wcol[1] + bflo(g0.y) * wcol[2] + bfhi(g0.y) * wcol[3] + bflo(g0.z) * wcol[4] + bfhi(g0.z) * wcol[5] + bflo(g0.w) * wcol[6] + bfhi(g0.w) * wcol[7];
                x += bflo(g1.x) * wcol[8] + bfhi(g1.x) * wcol[9] + bflo(g1.y) * wcol[10] + bfhi(g1.y) * wcol[11] + bflo(g1.z) * wcol[12] + bfhi(g1.z) * wcol[13] + bflo(g1.w) * wcol[14] + bfhi(g1.w) * wcol[15];
                const float ls = fminf(x, 0.f) - __logf(1.f + __expf(-fabsf(x)));
                cum += ls * (1.0f / 16.0f);
                const float q = bf2f(zr[zq + c]), k = bf2f(zr[zk + c]);
                const float eq = __expf(cum), ek = __expf(-cum);
                QP[(size_t)(chunk * C + t) * DK + c] = f2bf(q * eq * 0.17677669529663687f);
                KP[(size_t)(chunk * C + t) * DK + c] = f2bf(k * ek); }
            DG[chunk * 32 + c] = __expf(cum); }
    } else {
        const f32x2* sct = (const f32x2*)(ws + WS_SINCOS);
        for (int it = tid; it < SEQ * 32; it += 512) { const int t = it >> 5, i = it & 31; const bf16_t* zr = z + (rowbase + t) * ZW;
            const f32x2 sc = sct[it];
            const unsigned q2 = *(const unsigned*)(zr + zq + 2 * i), k2 = *(const unsigned*)(zr + zk + 2 * i);
            const float qa = bflo(q2), qb_ = bfhi(q2), ka = bflo(k2), kb_ = bfhi(k2);
            const float qr0 = qa * sc.y - qb_ * sc.x, qr1 = qb_ * sc.y + qa * sc.x, kr0 = ka * sc.y - kb_ * sc.x, kr1 = kb_ * sc.y + ka * sc.x;
            const float e = (float)((t & (C - 1)) + 1) * log2g; const float dq = __builtin_amdgcn_exp2f(e), dk = 0.125f * __builtin_amdgcn_exp2f(-e);
            *(unsigned*)(QP + (size_t)t * DK + 2 * i) = pk2(qr0 * dq, qr1 * dq); *(unsigned*)(KP + (size_t)t * DK + 2 * i) = pk2(kr0 * dk, kr1 * dk); }
    }
    for (int i = tid; i < ST_BYTES / 4; i += 512) ((LAS unsigned*)(lds + OFF_ST))[i] = 0u;
    __syncthreads();
    u32x4 rqk[NQK], rv[NVP];
#define ISSUE_LOADS(ci_) do { \
    _Pragma("unroll") for (int j = 0; j < NQK; ++j) { const int idx = tid + 512 * j; \
        if (idx < 2 * NQ) { const bool isk = idx >= NQ; const int id = isk ? idx - NQ : idx; rqk[j] = *(const u32x4*)((isk ? KP : QP) + (size_t)(ci_) * C * DK + (size_t)id * 8); } } \
    _Pragma("unroll") for (int j = 0; j < NVP; ++j) { const int idx = tid + 512 * j, row = idx >> 3, ch = idx & 7; rv[j] = *(const u32x4*)(z + (rowbase + (size_t)(ci_) * C + row) * ZW + zv + ch * 8); } \
    } while (0)
    ISSUE_LOADS(0);
    f32x16 Sacc = zero16();
    const float gC = __builtin_amdgcn_exp2f((float)C * log2g);
    for (int ci = 0; ci < NC; ++ci) {
        __syncthreads();
#pragma unroll
        for (int j = 0; j < NQK; ++j) { const int idx = tid + 512 * j;
            if (idx < 2 * NQ) { const bool isk = idx >= NQ; const int id = isk ? idx - NQ : idx; const int row = id / (DK / 8), ch = id % (DK / 8);
                *(LAS u32x4*)(lds + (isk ? OFF_K : OFF_Q) + row * PQ + ch * 16) = rqk[j]; } }
#pragma unroll
        for (int j = 0; j < NVP; ++j) { const int idx = tid + 512 * j, row = idx >> 3, ch = idx & 7; *(LAS u32x4*)(lds + OFF_V + row * PV + ch * 16) = rv[j]; }
        __syncthreads();
        if (ci + 1 < NC) ISSUE_LOADS(ci + 1);
        const LAS unsigned char* Ql = lds + OFF_Q; const LAS unsigned char* Kl = lds + OFF_K; const LAS unsigned char* Vl = lds + OFF_V;
        const LAS unsigned char* STr = lds + OFF_ST + (ci & 1) * ST_BYTES; LAS unsigned char* STw = lds + OFF_ST + ((ci + 1) & 1) * ST_BYTES;
        if (w < NTT) {
            const int tt = w;
            bf16x8 bq[NKS];
#pragma unroll
            for (int ks = 0; ks < NKS; ++ks) bq[ks] = frag_row(Ql, PQ, 32 * tt + r, (16 * ks + 8 * hh) * 2);
            f32x16 o0 = zero16(), o1 = zero16();
#pragma unroll
            for (int st = 0; st < NTT; ++st) {
                if (st <= tt) {
                    f32x16 Xs = zero16();
#pragma unroll
                    for (int ks = 0; ks < NKS; ++ks) Xs = MFMA32(frag_row(Kl, PQ, 32 * st + r, (16 * ks + 8 * hh) * 2), bq[ks], Xs);
                    if (st == tt) {
#pragma unroll
                        for (int reg = 0; reg < 16; ++reg) if (crow(reg, hh) > r) Xs[reg] = 0.f;
                    }
                    const bf16x8 x0 = pack8<0>(Xs), x1 = pack8<1>(Xs);
                    o0 = MFMA32(frag_tr(Vl, PV, 32 * st + 4 * hh, 32 * st + 8 + 4 * hh, 0, lane), x0, o0);
                    o1 = MFMA32(frag_tr(Vl, PV, 32 * st + 4 * hh, 32 * st + 8 + 4 * hh, 32, lane), x0, o1);
                    o0 = MFMA32(frag_tr(Vl, PV, 32 * st + 16 + 4 * hh, 32 * st + 24 + 4 * hh, 0, lane), x1, o0);
                    o1 = MFMA32(frag_tr(Vl, PV, 32 * st + 16 + 4 * hh, 32 * st + 24 + 4 * hh, 32, lane), x1, o1);
                }
            }
#pragma unroll
            for (int ks = 0; ks < NKS; ++ks) { const int kbyte = (16 * ks + 8 * hh) * 2;
                o0 = MFMA32(frag_row(STr, PQ, r, kbyte), bq[ks], o0); o1 = MFMA32(frag_row(STr, PQ, 32 + r, kbyte), bq[ks], o1); }
            float ss = 0.f;
#pragma unroll
            for (int reg = 0; reg < 16; ++reg) ss += o0[reg] * o0[reg] + o1[reg] * o1[reg];
            ss += __shfl_xor(ss, 32);
            const float rn = __builtin_amdgcn_rsqf(ss * (1.0f / 64.0f) + HN_EPS);
            const size_t row = rowbase + (size_t)ci * C + 32 * tt + r;
            const bf16_t* grow = z + row * ZW + zg; bf16_t* orow = mixed + row * DM + mcol;
#pragma unroll
            for (int vt = 0; vt < 2; ++vt)
#pragma unroll
                for (int rg = 0; rg < 4; ++rg) { const int v0 = 32 * vt + 8 * rg + 4 * hh; const u32x2 gt2 = *(const u32x2*)(grow + v0);
                    float gv[4] = {bflo(gt2.x), bfhi(gt2.x), bflo(gt2.y), bfhi(gt2.y)}; float res[4];
                    f32x4 gn = {1.f, 1.f, 1.f, 1.f}; if constexpr (GLA) gn = *(const f32x4*)(ngain + v0);
#pragma unroll
                    for (int i = 0; i < 4; ++i) { const float ov = (vt == 0 ? o0[4 * rg + i] : o1[4 * rg + i]) * rn * gn[i]; res[i] = ov * gv[i] * sigmoidf_(gv[i]); }
                    u32x2 o; o.x = pk2(res[0], res[1]); o.y = pk2(res[2], res[3]); *(u32x2*)(orow + v0) = o; }
        } else if (w < NTT + 2 * (DK / 32)) {
            const int kw = w - NTT, vt = kw & 1, ct = kw >> 1;
#pragma unroll
            for (int k2 = 0; k2 < C / 16; ++k2) { const int kb = 16 * k2 + 8 * hh;
                Sacc = MFMA32(frag_tr(Vl, PV, kb, kb + 4, 32 * vt, lane), frag_tr(Kl, PQ, kb, kb + 4, 32 * ct, lane), Sacc); }
            float d; if constexpr (GLA) d = DG[ci * 32 + r]; else d = gC;
#pragma unroll
            for (int reg = 0; reg < 16; ++reg) { Sacc[reg] *= d; *(LAS bf16_t*)(STw + (32 * vt + crow(reg, hh)) * PQ + (32 * ct + r) * 2) = f2bf(Sacc[reg]); }
        }
    }
    __syncthreads();
#undef ISSUE_LOADS
}

NI void ph_p4(LAS unsigned char* lds_, unsigned char* ws_, const float* wr_, const float* br_, const float* lng_, const float* lnb_, int L_, int G_, int blk_) {
    Ctx X = make_ctx(lds_, uni(ws_), rfl(G_), rfl(blk_)); const int L = rfl(L_);
    const float* const wr = uni(wr_); const float* const brp = uni(br_); const float* const lngp = uni(lng_); const float* const lnbp = uni(lnb_);
    unsigned char* ws = X.ws; LAS unsigned char* lds = X.lds;
    LAS float* wrT = (LAS float*)lds;
    LAS int* sel_e = (LAS int*)(lds + 131072 + 1024); LAS float* sel_g = (LAS float*)(lds + 131072 + 1024 + 2048);
    LAS unsigned* hist = (LAS unsigned*)(lds + 131072 + 1024 + 4096); LAS unsigned* base = hist + 32;
    for (int i = X.tid; i < DM * NEXP; i += 512) { const int k = i >> 5, e = i & 31; wrT[e * 1024 + k] = wr[i]; }
    const float* Y1 = (const float*)(ws + WS_Y1); float* X1 = (float*)(ws + WS_X1); bf16_t* X1B = (bf16_t*)(ws + WS_X1B);
    int* list = (int*)(ws + WS_LIST); int* asg = (int*)(ws + WS_ASG); float* gate = (float*)(ws + WS_GATE);
    unsigned* cnt = X.ctl + CW_CNT + L * NEXP;
    const int lane = X.lane;
    f32x4 lg[4], lb[4];
#pragma unroll
    for (int j = 0; j < 4; ++j) { lg[j] = *(const f32x4*)(lngp + 4 * lane + 256 * j); lb[j] = *(const f32x4*)(lnbp + 4 * lane + 256 * j); }
    const float brl = brp[lane >> 1];
    __syncthreads();
    for (int grp = X.blk; grp < NTOK / 128; grp += X.G) {
        if (X.tid < 32) hist[X.tid] = 0u;
        for (int rl = 0; rl < 16; ++rl) { const int rloc = X.wave * 16 + rl; const size_t row = (size_t)grp * 128 + rloc;
            f32x4 v[4]; float s = 0.f;
#pragma unroll
            for (int j = 0; j < 4; ++j) { v[j] = *(const f32x4*)(Y1 + row * DM + 4 * lane + 256 * j); s += (v[j][0] + v[j][1]) + (v[j][2] + v[j][3]); }
            const float mean = wave_sum(s) * (1.f / DM); float s2 = 0.f;
#pragma unroll
            for (int j = 0; j < 4; ++j) { v[j] = v[j] - mean; s2 += (v[j][0] * v[j][0] + v[j][1] * v[j][1]) + (v[j][2] * v[j][2] + v[j][3] * v[j][3]); }
            const float rstd = __builtin_amdgcn_rsqf(wave_sum(s2) * (1.f / DM) + LN_EPS);
#pragma unroll
            for (int j = 0; j < 4; ++j) { v[j] = v[j] * rstd * lg[j] + lb[j]; *(f32x4*)(X1 + row * DM + 4 * lane + 256 * j) = v[j];
                u32x2 o; o.x = pk2(v[j][0], v[j][1]); o.y = pk2(v[j][2], v[j][3]); *(u32x2*)(X1B + row * DM + 4 * lane + 256 * j) = o; }
            float pe[32];
#pragma unroll
            for (int e = 0; e < 32; ++e) { float a = 0.f;
#pragma unroll
                for (int j = 0; j < 4; ++j) { const f32x4 wv = *(const LAS f32x4*)(wrT + e * 1024 + 4 * lane + 256 * j); a += (v[j][0] * wv[0] + v[j][1] * wv[1]) + (v[j][2] * wv[2] + v[j][3] * wv[3]); }
                pe[e] = a; }
            float p16[16], p8[8], p4[4], p2[2], p1;
            { const bool up = (lane & 32) != 0;
#pragma unroll
              for (int i = 0; i < 16; ++i) { const float send = up ? pe[i] : pe[i + 16], keep = up ? pe[i + 16] : pe[i]; p16[i] = keep + __shfl_xor(send, 32); } }
            { const bool up = (lane & 16) != 0;
#pragma unroll
              for (int i = 0; i < 8; ++i) { const float send = up ? p16[i] : p16[i + 8], keep = up ? p16[i + 8] : p16[i]; p8[i] = keep + __shfl_xor(send, 16); } }
            { const bool up = (lane & 8) != 0;
#pragma unroll
              for (int i = 0; i < 4; ++i) { const float send = up ? p8[i] : p8[i + 4], keep = up ? p8[i + 4] : p8[i]; p4[i] = keep + __shfl_xor(send, 8); } }
            { const bool up = (lane & 4) != 0;
#pragma unroll
              for (int i = 0; i < 2; ++i) { const float send = up ? p4[i] : p4[i + 2], keep = up ? p4[i + 2] : p4[i]; p2[i] = keep + __shfl_xor(send, 4); } }
            { const bool up = (lane & 2) != 0; const float send = up ? p2[0] : p2[1], keep = up ? p2[1] : p2[0]; p1 = keep + __shfl_xor(send, 2); }
            p1 += __shfl_xor(p1, 1);
            float lv = p1 + brl; const int le = lane >> 1;
            float tv[4]; int te[4];
#pragma unroll
            for (int k = 0; k < 4; ++k) { float bv = lv; int be = le;
#pragma unroll
                for (int o = 1; o < 64; o <<= 1) { const float ov = __shfl_xor(bv, o); const int oe = __shfl_xor(be, o); const bool take = (ov > bv) || (ov == bv && oe < be); bv = take ? ov : bv; be = take ? oe : be; }
                tv[k] = bv; te[k] = be; if (le == be) lv = -3.0e38f; }
            const float e1 = __expf(tv[1] - tv[0]), e2 = __expf(tv[2] - tv[0]), e3 = __expf(tv[3] - tv[0]); const float rs = 1.0f / (1.0f + e1 + e2 + e3);
            if (lane == 0) { sel_e[rloc * 4 + 0] = te[0]; sel_e[rloc * 4 + 1] = te[1]; sel_e[rloc * 4 + 2] = te[2]; sel_e[rloc * 4 + 3] = te[3];
                sel_g[rloc * 4 + 0] = rs; sel_g[rloc * 4 + 1] = e1 * rs; sel_g[rloc * 4 + 2] = e2 * rs; sel_g[rloc * 4 + 3] = e3 * rs; }
        }
        __syncthreads();
        const int e = sel_e[X.tid]; const float g = sel_g[X.tid];
        const unsigned rank = __hip_atomic_fetch_add(hist + e, 1u, __ATOMIC_RELAXED, __HIP_MEMORY_SCOPE_WORKGROUP);
        __syncthreads();
        if (X.tid < 32) base[X.tid] = __hip_atomic_fetch_add(cnt + X.tid, hist[X.tid], RLX_AGENT);
        __syncthreads();
        const unsigned pos = base[e] + rank; const int tok = grp * 128 + (X.tid >> 2);
        list[(size_t)e * NTOK + pos] = tok; asg[(size_t)tok * 4 + (X.tid & 3)] = (e << 16) | (int)pos; gate[(size_t)tok * 4 + (X.tid & 3)] = g;
        __syncthreads();
    }
}

DI void load_pfx(Ctx& X, int L) {
    __syncthreads();
    if (X.tid == 0) { int acc = 0; const unsigned* cnt = X.ctl + CW_CNT + L * NEXP;
        for (int e = 0; e < NEXP; ++e) { const int c = (int)cnt[e]; X.MISC[MW_PFX + e] = (unsigned)acc; X.MISC[MW_CNT + e] = (unsigned)c; acc += (c + 255) >> 8; }
        X.MISC[MW_PFX + NEXP] = (unsigned)acc; }
    __syncthreads();
}

NI void ph_p7(LAS unsigned char* lds_, unsigned char* ws_, const float* lng_, const float* lnb_, float* xout_, int L_, int G_, int blk_) {
    Ctx X = make_ctx(lds_, uni(ws_), rfl(G_), rfl(blk_)); const int L = rfl(L_);
    const float* const lngp = uni(lng_); const float* const lnbp = uni(lnb_); float* const xout = uni(xout_);
    load_pfx(X, L);
    unsigned char* ws = X.ws;
    const float* X1 = (const float*)(ws + WS_X1); const bf16_t* EP = (const bf16_t*)(ws + WS_EP); const bf16_t* YB = (const bf16_t*)(ws + WS_YB);
    const int* asg = (const int*)(ws + WS_ASG); const float* gate = (const float*)(ws + WS_GATE); bf16_t* XB = (bf16_t*)(ws + WS_XB);
    const int lane = X.lane;
    f32x4 lg[4], lb[4];
#pragma unroll
    for (int j = 0; j < 4; ++j) { lg[j] = *(const f32x4*)(lngp + 4 * lane + 256 * j); lb[j] = *(const f32x4*)(lnbp + 4 * lane + 256 * j); }
    const int gw = X.blk * 8 + X.wave, NGW = X.G * 8;
    for (int row = gw; row < NTOK; row += NGW) {
        f32x4 v[4];
#pragma unroll
        for (int j = 0; j < 4; ++j) { const f32x4 x1 = *(const f32x4*)(X1 + (size_t)row * DM + 4 * lane + 256 * j); const u32x2 ep = *(const u32x2*)(EP + (size_t)row * DM + 4 * lane + 256 * j);
            v[j] = x1 * DN_ALPHA + (f32x4){bflo(ep.x), bfhi(ep.x), bflo(ep.y), bfhi(ep.y)}; }
#pragma unroll
        for (int k = 0; k < 4; ++k) { const int a = asg[(size_t)row * 4 + k]; const float g = gate[(size_t)row * 4 + k]; const int e = a >> 16, pos = a & 0xffff;
            const size_t slot = (size_t)X.MISC[MW_PFX + e] * 256 + pos; const bf16_t* yr = YB + slot * DM;
#pragma unroll
            for (int j = 0; j < 4; ++j) { const u32x2 y = *(const u32x2*)(yr + 4 * lane + 256 * j); v[j] = v[j] + (f32x4){bflo(y.x), bfhi(y.x), bflo(y.y), bfhi(y.y)} * g; } }
        float s = 0.f;
#pragma unroll
        for (int j = 0; j < 4; ++j) s += (v[j][0] + v[j][1]) + (v[j][2] + v[j][3]);
        const float mean = wave_sum(s) * (1.f / DM); float s2 = 0.f;
#pragma unroll
        for (int j = 0; j < 4; ++j) { v[j] = v[j] - mean; s2 += (v[j][0] * v[j][0] + v[j][1] * v[j][1]) + (v[j][2] * v[j][2] + v[j][3] * v[j][3]); }
        const float rstd = __builtin_amdgcn_rsqf(wave_sum(s2) * (1.f / DM) + LN_EPS);
#pragma unroll
        for (int j = 0; j < 4; ++j) { v[j] = v[j] * rstd * lg[j] + lb[j]; *(f32x4*)(xout + (size_t)row * DM + 4 * lane + 256 * j) = v[j];
            u32x2 o; o.x = pk2(v[j][0], v[j][1]); o.y = pk2(v[j][2], v[j][3]); *(u32x2*)(XB + (size_t)row * DM + 4 * lane + 256 * j) = o; }
    }
}

NI void ph_gemm_in(LAS unsigned char* lds, const bf16_t* A_, const bf16_t* B_, bf16_t* O_, int G_, int blk_) {
    pg8::StaticOrder S; S.init(NTOK, ZW, rfl(G_), rfl(blk_));
    pg8::EpiBf16 E{uni(O_), ZW, nullptr, 0};
    pg8::gemm_phase<pg8::EpiBf16, pg8::StaticOrder, pg8::NoGather, true>(lds, uni(A_), uni(B_), DM, S, E, pg8::NoGather{});
}
NI void ph_gemm_out(LAS unsigned char* lds, const bf16_t* A_, const bf16_t* B_, const float* X_, float* Y_, int G_, int blk_) {
    pg8::StaticOrder S; S.init(NTOK, DM, rfl(G_), rfl(blk_));
    pg8::EpiResid E{uni(X_), uni(Y_), DN_ALPHA};
    pg8::gemm_phase<pg8::EpiResid, pg8::StaticOrder, pg8::NoGather, true>(lds, uni(A_), uni(B_), DM, S, E, pg8::NoGather{});
}
NI void ph_gemm_pp(LAS unsigned char* lds, const bf16_t* A_, const bf16_t* B_, bf16_t* O_, int G_, int blk_) {
    pg8::StaticOrder S; S.init(NTOK, DM, rfl(G_), rfl(blk_));
    pg8::EpiBf16 E{uni(O_), DM, nullptr, 0};
    pg8::gemm_phase<pg8::EpiBf16, pg8::StaticOrder, pg8::NoGather, true>(lds, uni(A_), uni(B_), PLE, S, E, pg8::NoGather{});
}
NI void ph_gemm_gu(LAS unsigned char* lds, unsigned char* ws_, const bf16_t* A_, const bf16_t* B_, bf16_t* O_, const float* bias_, const int* list_, int L_, int G_, int blk_) {
    Ctx X = make_ctx(lds, uni(ws_), rfl(G_), rfl(blk_)); load_pfx(X, rfl(L_));
    pg8::MoeOrder S; S.init((const LAS int*)(lds + MISC_OFF) + MW_PFX, (const LAS int*)(lds + MISC_OFF) + MW_CNT, 8, X.G, X.blk);
    pg8::EpiSwiglu E{uni(O_), uni(bias_)};
    pg8::MoeGather Gt{uni(list_)};
    pg8::gemm_phase<pg8::EpiSwiglu, pg8::MoeOrder, pg8::MoeGather, true>(lds, uni(A_), uni(B_), DM, S, E, Gt);
}
NI void ph_gemm_pg(LAS unsigned char* lds, const bf16_t* A_, const bf16_t* B_, bf16_t* O_, const bf16_t* PP_, const float* bias_, int G_, int blk_) {
    pg8::StaticOrder S; S.init(NTOK, DM, rfl(G_), rfl(blk_));
    pg8::EpiPle E{uni(O_), uni(PP_), uni(bias_)};
    pg8::gemm_phase<pg8::EpiPle, pg8::StaticOrder, pg8::NoGather, true>(lds, uni(A_), uni(B_), DM, S, E, pg8::NoGather{});
}
NI void ph_gemm_dn(LAS unsigned char* lds, unsigned char* ws_, const bf16_t* A_, const bf16_t* B_, bf16_t* O_, const float* bias_, int L_, int G_, int blk_) {
    Ctx X = make_ctx(lds, uni(ws_), rfl(G_), rfl(blk_)); load_pfx(X, rfl(L_));
    pg8::MoeOrder S; S.init((const LAS int*)(lds + MISC_OFF) + MW_PFX, (const LAS int*)(lds + MISC_OFF) + MW_CNT, 4, X.G, X.blk);
    pg8::EpiBf16 E{uni(O_), DM, uni(bias_), DM};
    pg8::gemm_phase<pg8::EpiBf16, pg8::MoeOrder, pg8::NoGather, true>(lds, uni(A_), uni(B_), DFF, S, E, pg8::NoGather{});
}
NI void ph_p2(LAS unsigned char* lds, unsigned char* ws_, const float* relb_, const float* dlam_, const float* dnorm_, const float* wg_, const float* bg_, const float* gng_, int L_, int G_, int blk_) {
    Ctx X = make_ctx(lds, uni(ws_), rfl(G_), rfl(blk_)); const int L = rfl(L_); unsigned char* const ws = X.ws;
    const float* const relb = uni(relb_); const float* const dl = uni(dlam_); const float* const dnorm = uni(dnorm_);
    const float lam_init = L == 0 ? 0.20000000000000007f : L == 1 ? 0.35550906759096934f : L == 2 ? 0.4707130183435842f : 0.5560582041556406f;
    { const int hq = X.tid >> 7, n = X.tid & 127; int bk;
      if (n < 16) bk = n; else { bk = 16 + (int)(__logf((float)n * (1.0f / 16.0f)) / __logf(8.0f) * 16.0f); bk = bk > 31 ? 31 : bk; }
      ((LAS float*)(lds + AT_BIAS_OFF))[hq * 128 + n] = relb[bk * 4 + hq] * LOG2E; }
    float lam;
    { float s1 = 0.f, s2 = 0.f;
      for (int d = 0; d < 64; ++d) { s1 += dl[d] * dl[64 + d]; s2 += dl[128 + d] * dl[192 + d]; }
      lam = __expf(s1) - __expf(s2) + lam_init; }
    __syncthreads();
#ifndef NO_GLA
    for (int s = X.blk; s < 32; s += X.G) stream_run<64, 32, true>(lds, ws, wg_, bg_, gng_, s, s >> 2, s & 3);
#endif
#ifndef NO_RET
    for (int s = (X.blk + X.G - (32 % X.G)) % X.G; s < 32; s += X.G) stream_run<128, 64, false>(lds, ws, wg_, bg_, gng_, 32 + s, s >> 2, s & 3);
#endif
#ifndef NO_ATT
    unsigned* qhead = X.ctl + CW_Q + 64 * L;
    for (;;) {
        if (X.tid == 0) X.MISC[MW_Q] = __hip_atomic_fetch_add(qhead, 1u, RLX_AGENT);
        __syncthreads();
        const int u = rfl((int)X.MISC[MW_Q]);
        __syncthreads();
        if (u >= 1024) break;
        const int qb = 31 - (u >> 5), bh = u & 31;
        attn_unit(lds, (const bf16_t*)(ws + WS_Z), (bf16_t*)(ws + WS_MIX), bh >> 2, bh & 3, qb, lam, 1.0f - lam_init, dnorm);
    }
#endif
}

constexpr int NPH = 1 + DEPTH * 7;
__global__ void __launch_bounds__(512, 2) fwd_kernel(Args args) {
    extern __shared__ __attribute__((aligned(16))) unsigned char lds_raw[];
    LAS unsigned char* const lds = (LAS unsigned char*)lds_raw;
    volatile LAS unsigned* const MISC = (volatile LAS unsigned*)(lds + MISC_OFF);
    unsigned char* const ws = args.ws; unsigned* const ctl = (unsigned*)(ws + WS_CTL);
    const int G = gridDim.x, blk = blockIdx.x;
    for (int u = threadIdx.x; u < 1024; u += 512) ((LAS unsigned*)(lds + MISC_OFF))[u] = 0u;
    __syncthreads();
#if MK_SPLIT
#define GRID_BAR() do { } while (0)
#else
    XcdBarrier bar = xcd_barrier_post(ctl + CW_BAR, MISC + MW_BAR);
#define GRID_BAR() xcd_barrier(bar)
#endif
    const int lo = args.ph_lo, hi = args.ph_hi;
#define IN(k) (lo <= (k) && (k) < hi)
#define SEAM(k) do { if (IN((k) + 1)) GRID_BAR(); } while (0)
    bf16_t* const XB = (bf16_t*)(ws + WS_XB); bf16_t* const Zb = (bf16_t*)(ws + WS_Z); bf16_t* const MIX = (bf16_t*)(ws + WS_MIX);
    float* const Y1 = (float*)(ws + WS_Y1); bf16_t* const X1B = (bf16_t*)(ws + WS_X1B); bf16_t* const PP = (bf16_t*)(ws + WS_PP); bf16_t* const EP = (bf16_t*)(ws + WS_EP);
    bf16_t* const ACT = (bf16_t*)(ws + WS_ACT); bf16_t* const YB = (bf16_t*)(ws + WS_YB);

#ifndef NO_P0
    if (IN(0)) { ph_p0(lds, ws, args.in[0], args.in[1], args.in[2], args.in[8], args.in[14], args.in[16], args.in[18], args.in[20], G, blk); SEAM(0); }
#endif
    for (int L = 0; L < DEPTH; ++L) {
        const int pb = 1 + L * 7;
#ifndef NO_P1
        if (IN(pb + 0)) { ph_gemm_in(lds, XB, (const bf16_t*)(ws + WS_WIN) + (size_t)L * ZW * DM, Zb, G, blk); SEAM(pb + 0); }
#endif
#ifndef NO_P2
        if (IN(pb + 1)) { ph_p2(lds, ws, args.in[9], args.in[6] + (size_t)L * 256, args.in[7] + (size_t)L * 128, args.in[3] + (size_t)L * 16 * 128, args.in[4] + (size_t)L * 128, args.in[5] + (size_t)L * 64, L, G, blk); SEAM(pb + 1); }
#endif
#ifndef NO_P3
        if (IN(pb + 2)) {
            ph_gemm_out(lds, MIX, (const bf16_t*)(ws + WS_WOUT) + (size_t)L * DM * DM, L == 0 ? args.in[0] : (const float*)args.out, Y1, G, blk);
            ph_gemm_pp(lds, (const bf16_t*)(ws + WS_PB) + (size_t)L * NTOK * PLE, (const bf16_t*)(ws + WS_WPP) + (size_t)L * DM * PLE, PP, G, blk);
            SEAM(pb + 2);
        }
#endif
#ifndef NO_P4
        if (IN(pb + 3)) { ph_p4(lds, ws, args.in[12] + (size_t)L * DM * NEXP, args.in[13] + (size_t)L * NEXP, args.in[10] + (size_t)L * DM, args.in[11] + (size_t)L * DM, L, G, blk); SEAM(pb + 3); }
#endif
#ifndef NO_P5
        if (IN(pb + 4)) {
            ph_gemm_gu(lds, ws, X1B, (const bf16_t*)(ws + WS_WGU) + (size_t)L * NEXP * 2048 * DM, ACT, args.in[15] + (size_t)L * NEXP * 2048, (const int*)(ws + WS_LIST), L, G, blk);
            ph_gemm_pg(lds, X1B, (const bf16_t*)(ws + WS_WPG) + (size_t)L * DM * DM, EP, PP, args.in[19] + (size_t)L * DM, G, blk);
            SEAM(pb + 4);
        }
#endif
#ifndef NO_P6
        if (IN(pb + 5)) { ph_gemm_dn(lds, ws, ACT, (const bf16_t*)(ws + WS_WDN) + (size_t)L * NEXP * DM * DFF, YB, args.in[17] + (size_t)L * NEXP * DM, L, G, blk); SEAM(pb + 5); }
#endif
#ifndef NO_P7
        if (IN(pb + 6)) { ph_p7(lds, ws, args.in[21] + (size_t)L * DM, args.in[22] + (size_t)L * DM, args.out, L, G, blk); if (L + 1 < DEPTH) SEAM(pb + 6); }
#endif
    }
#undef IN
#undef SEAM
}

extern "C" void kernel_launch(void* const* d_in, const int* in_sizes, int n_in, void* d_out, int out_size, void* d_ws, size_t ws_size, hipStream_t stream) {
    static int grid = 0;
    if (grid == 0) {
        if (n_in != 23 || out_size != NTOK * DM || ws_size < WS_END) { fprintf(stderr, "kernel_launch: unexpected shapes (n_in %d, out %d, ws %zu < %zu)\n", n_in, out_size, ws_size, (size_t)WS_END); grid = -1; return; }
        int dev = 0, cus = 0, per_cu = 0;
        if (hipGetDevice(&dev) != hipSuccess || hipDeviceGetAttribute(&cus, hipDeviceAttributeMultiprocessorCount, dev) != hipSuccess) { grid = -1; return; }
        if (hipFuncSetAttribute((const void*)fwd_kernel, hipFuncAttributeMaxDynamicSharedMemorySize, LDS_BYTES) != hipSuccess) { fprintf(stderr, "kernel_launch: hipFuncSetAttribute failed\n"); grid = -1; return; }
        if (hipOccupancyMaxActiveBlocksPerMultiprocessor(&per_cu, (const void*)fwd_kernel, 512, LDS_BYTES) != hipSuccess || per_cu < 1) { fprintf(stderr, "kernel_launch: occupancy query says %d\n", per_cu); }
        (void)hipGetLastError();
        grid = cus;
    }
    if (grid < 0) return;
    (void)hipMemsetAsync((char*)d_ws + WS_CTL, 0, CTL_ZERO_BYTES, stream);
    Args a{};
    for (int i = 0; i < 23; ++i) a.in[i] = (const float*)d_in[i];
    a.out = (float*)d_out; a.ws = (unsigned char*)d_ws;
#if MK_SPLIT
    for (int p = 0; p < NPH; ++p) { a.ph_lo = p; a.ph_hi = p + 1; hipLaunchKernelGGL(fwd_kernel, dim3(grid), dim3(512), LDS_BYTES, stream, a); }
#else
    a.ph_lo = 0; a.ph_hi = NPH;
    hipLaunchKernelGGL(fwd_kernel, dim3(grid), dim3(512), LDS_BYTES, stream, a);
#endif
}
```

```cpp
#include <hip/hip_runtime.h>
#include <cstdio>
#include <cstdint>

#ifndef DUP_MASK
#define DUP_MASK 0
#endif
#ifndef PROBE_ID
#define PROBE_ID -1
#endif
#define PROBE_BLK (PROBE_ID == 21 ? 32 : (PROBE_ID == 22 || PROBE_ID == 28) ? 64 : 0)
#define TP_BEGIN(id) do { if (PROBE_ID == (id) && blockIdx.x == PROBE_BLK) { tp_t0 = __builtin_amdgcn_s_memrealtime(); } } while (0)
#define TP_END(id) do { if (PROBE_ID == (id) && blockIdx.x == PROBE_BLK) { tp_acc += __builtin_amdgcn_s_memrealtime() - tp_t0; } } while (0)
#ifndef F8_MOE
#define F8_MOE 1
#endif
#ifndef F8_OUT
#define F8_OUT 0
#endif
#ifndef F8_IN
#define F8_IN 0
#endif
#ifndef F8_PG
#define F8_PG 1
#endif
#ifndef MK_SPLIT
#define MK_SPLIT 0
#endif

#define GAS __attribute__((address_space(1)))
#define LAS __attribute__((address_space(3)))
#define DI __device__ __forceinline__
typedef unsigned short bf16_t;
typedef short bf16x8 __attribute__((ext_vector_type(8)));
typedef short s16x4 __attribute__((ext_vector_type(4)));
typedef short v4i16_t __attribute__((ext_vector_type(4)));
typedef float f32x2 __attribute__((ext_vector_type(2)));
typedef float f32x4 __attribute__((ext_vector_type(4)));
typedef float f32x16 __attribute__((ext_vector_type(16)));
typedef unsigned u32x2 __attribute__((ext_vector_type(2)));
typedef unsigned u32x4 __attribute__((ext_vector_type(4)));
typedef __bf16 bf16x2_t __attribute__((ext_vector_type(2)));
typedef int v4i_t __attribute__((ext_vector_type(4)));
typedef int v8i_t __attribute__((ext_vector_type(8)));

constexpr int NB = 8, SEQ = 4096, DM = 1024, DEPTH = 4, NTOK = NB * SEQ;
constexpr int INW = 3344;
constexpr int ZW = 3584;
constexpr int ZC_GQ = 0, ZC_GK = 128, ZC_GV = 256, ZC_GO = 512, ZC_DQ = 768, ZC_DK = 1280, ZC_DV = 1792,
              ZC_RQ = 2304, ZC_RK = 2560, ZC_RV = 2816, ZC_RG = 3072, ZC_LR = 3328;
constexpr int NEXP = 32, TOPK = 4, DFF = 1024, PLE = 256;
constexpr int MAXSLOT = NTOK * TOPK + NEXP * 256;
constexpr float LN_EPS = 1e-5f, HN_EPS = 1e-5f;
constexpr float DN_ALPHA = 1.681792830507429f;
constexpr float LOG2E = 1.4426950408889634f;

__device__ const double kThetaRev[32] = {0.15915494309189535, 0.11824638530245714, 0.08785280158734302, 0.06527146455262238, 0.04849434517587465, 0.036029550281362475, 0.02676865702112893, 0.01988814717694384,
    0.01477617639986849, 0.010978166395165499, 0.008156381877047283, 0.0060598977032741905, 0.004502285538822983, 0.0033450358513712635, 0.0024852410515669447, 0.0018464445102618582,
    0.0013718417082023314, 0.0010192289353426582, 0.0007572503565305745, 0.0005626097166019918, 0.00041799873778229564, 0.0003105579936352166, 0.00023073339389116236, 0.00017142659389752471,
    0.00012736377946734852, 9.462669677672228e-05, 7.03042244845543e-05, 5.2233504378126876e-05, 3.8807610774786524e-05, 2.8832655820772147e-05, 2.14216238794896e-05, 1.5915494309189534e-05};

constexpr size_t MiB = 1u << 20;
constexpr size_t WS_CTL = 0, CTL_ZERO_BYTES = 1 * MiB;
constexpr size_t WS_SINCOS = 1 * MiB;
constexpr size_t WS_LIST = 2 * MiB;
constexpr size_t WS_ASG = 6 * MiB;
constexpr size_t WS_GATE = 7 * MiB;
constexpr size_t WS_WIN = 8 * MiB;
constexpr size_t WS_WOUT = 36 * MiB;
constexpr size_t WS_WPG = 44 * MiB;
constexpr size_t WS_WPP = 52 * MiB;
constexpr size_t WS_WGU = 64 * MiB;
constexpr size_t WS_WDN = 576 * MiB;
constexpr size_t WS_XB = 832 * MiB;
constexpr size_t WS_X1 = 896 * MiB;
constexpr size_t WS_X1B = 1024 * MiB;
constexpr size_t WS_Y1 = 1088 * MiB;
constexpr size_t WS_Z = 1216 * MiB;
constexpr size_t WS_MIX = 1440 * MiB;
constexpr size_t WS_PB = 1504 * MiB;
constexpr size_t WS_PP = 1568 * MiB;
constexpr size_t WS_EP = 1632 * MiB;
constexpr size_t WS_ACT = 1696 * MiB;
constexpr size_t WS_YB = 1968 * MiB;
constexpr size_t WS_GS = 2240 * MiB;
constexpr size_t WS_X1F8 = 2240 * MiB + 64 * 2 * MiB;
constexpr size_t GS_STRIDE = 2 * MiB;
constexpr size_t WS_END = WS_X1F8 + 32 * MiB;
static_assert(WS_ACT + (size_t)MAXSLOT * 1024 * 2 <= WS_YB && WS_YB + (size_t)MAXSLOT * 1024 * 2 <= WS_GS, "ws map");
constexpr int CW_BAR = 4096;
constexpr int CW_CNT = 8192;
constexpr int CW_Q = 8704;

constexpr int RING_BYTES = 131072;
constexpr int MISC_OFF = RING_BYTES;
constexpr int LDS_BYTES = 163840;
constexpr int MW_BAR = 8, MW_Q = 16, MW_PFX = 32, MW_CNT = 96;

DI unsigned pk2(float lo, float hi) { f32x2 v = {lo, hi}; bf16x2_t b = __builtin_convertvector(v, bf16x2_t); return __builtin_bit_cast(unsigned, b); }
DI float bflo(unsigned w) { return __uint_as_float(w << 16); }
DI float bfhi(unsigned w) { return __uint_as_float(w & 0xffff0000u); }
DI float bf2f(bf16_t h) { return __uint_as_float((unsigned)h << 16); }
DI bf16_t f2bf(float f) { return (bf16_t)(pk2(f, 0.f) & 0xffffu); }
DI unsigned pk4_fp8(float a, float b, float c, float d) { int w = __builtin_amdgcn_cvt_pk_fp8_f32(a, b, 0, false); w = __builtin_amdgcn_cvt_pk_fp8_f32(c, d, w, true); return (unsigned)w; }
DI int rfl(int v) { return __builtin_amdgcn_readfirstlane(v); }
template <class T> DI T* uni(T* p) { const unsigned long long v = (unsigned long long)p; const unsigned lo = (unsigned)__builtin_amdgcn_readfirstlane((int)(unsigned)v), hi = (unsigned)__builtin_amdgcn_readfirstlane((int)(unsigned)(v >> 32));
    return (T*)(GAS T*)(((unsigned long long)hi << 32) | lo); }
DI float unif(float v) { return __uint_as_float((unsigned)__builtin_amdgcn_readfirstlane((int)__float_as_uint(v))); }
#define NI __device__ __forceinline__
DI int opaque_tid() { int t = (int)threadIdx.x; asm volatile("" : "+v"(t)); return t; }
DI float wave_sum(float v) {
#pragma unroll
    for (int o = 1; o < 64; o <<= 1) v += __shfl_xor(v, o);
    return v;
}
DI float sigmoidf_(float x) { return __builtin_amdgcn_rcpf(1.f + __builtin_amdgcn_exp2f(-x * LOG2E)); }

#ifndef EPI_NT
#define EPI_NT 0
#endif
#if EPI_NT
#define EPI_ST(p, v) __builtin_nontemporal_store((v), (p))
#else
#define EPI_ST(p, v) (*(p) = (v))
#endif
namespace pg8 {
constexpr int BM = 256, BK = 64, HALF = 128, HTB = HALF * BK * 2, STAGE_BYTES = 8 * HTB, NXCD = 8, WGM = 8;
__host__ __device__ __forceinline__ int lds_byte(int r, int c) { const int st = (r >> 4) * 2 + (c >> 5), rr = r & 15, cc = c & 31, ob = rr * 64 + cc * 2; return st * 1024 + (ob ^ (((ob >> 9) & 1) << 5)); }
__host__ __device__ __forceinline__ void stage_rc(int b, int& R, int& C) { const int st = b / 1024, sb = b % 1024, swz = sb ^ (((sb >> 9) & 1) << 5); R = (st >> 1) * 16 + swz / 64; C = (st & 1) * 32 + (swz % 64) / 2; }
__host__ __device__ __forceinline__ int perm32(int rho) { const int n = rho >> 4, i = rho & 15; return 8 * (i >> 2) + 4 * n + (i & 3); }

struct Unit { int pm, pn, pb, e, r0, cnt; };

DI void order_map(int L, int nM, int nN, int nwg, int& pm, int& pn) {
    int wgid = L; { const int q = nwg / NXCD, r = nwg % NXCD, xcd = wgid % NXCD, off = wgid / NXCD; wgid = (xcd < r ? xcd * (q + 1) : r * (q + 1) + (xcd - r) * q) + off; }
    const int nig = WGM * nN, gid = wgid / nig, fm = gid * WGM, gsz = (nM - fm) < WGM ? (nM - fm) : WGM;
    pm = fm + ((wgid % nig) % gsz); pn = (wgid % nig) / gsz;
}
struct StaticOrder {
    static constexpr bool IS_MOE = false;
    int nM, nN, nwg, G, c;
    DI void init(int M, int N, int G_, int c_) { nM = M / BM; nN = N / BM; nwg = nM * nN; G = G_; c = c_; }
    DI bool next(int i, Unit& u) const {
        const long L = (long)i * G + c; if (L >= nwg) return false;
        order_map((int)L, nM, nN, nwg, u.pm, u.pn); u.pb = u.pn; u.e = 0; u.r0 = 0; u.cnt = 0; return true;
    }
};
struct MoeOrder {
    static constexpr bool IS_MOE = true;
    const LAS int* tab;
    DI void init(const LAS int* pfx, const LAS int* cnts, int nN, int G, int c, LAS int* tab_) {
        tab = tab_; const int t = threadIdx.x;
        if (t < 20) { const int nM = pfx[NEXP], nwg = nM * nN; const long L = (long)t * G + c; int pm = -1, pn = 0, e = 0;
            if (L < nwg) { order_map((int)L, nM, nN, nwg, pm, pn);
                for (int j = 1; j < NEXP; ++j) { if (pfx[j] <= pm) e = j; } }
            tab_[t * 8 + 0] = pm; tab_[t * 8 + 1] = pn; tab_[t * 8 + 2] = e * nN + pn; tab_[t * 8 + 3] = e; tab_[t * 8 + 4] = pm < 0 ? 0 : (pm - pfx[e]) * BM; tab_[t * 8 + 5] = cnts[e]; }
        __syncthreads();
    }
    DI bool next(int i, Unit& u) const {
        if (i >= 20) return false;
        const int pm = rfl(tab[i * 8 + 0]); if (pm < 0) return false;
        u.pm = pm; u.pn = rfl(tab[i * 8 + 1]); u.pb = rfl(tab[i * 8 + 2]); u.e = rfl(tab[i * 8 + 3]); u.r0 = rfl(tab[i * 8 + 4]); u.cnt = rfl(tab[i * 8 + 5]); return true;
    }
};
struct NoGather { static constexpr bool ON = false; DI unsigned tok(const Unit&, int) const { return 0u; } };
struct MoeGather { static constexpr bool ON = true; const int* list;
    DI unsigned tok(const Unit& u, int row) const { const int p = u.r0 + row; return (unsigned)list[(size_t)u.e * NTOK + (p < u.cnt ? p : u.cnt - 1)]; } };

struct EpiBf16 {
    static constexpr bool PERM = true;
    bf16_t* O; int ldc; const float* bias; int bias_estride; float ascale;
    DI const float* bias_ptr(const Unit& u) const { return bias ? bias + (size_t)u.e * bias_estride + u.pn * BM : nullptr; }
    DI void operator()(const f32x4 (&acc)[2][2][4][2], const Unit& u, int wr, int wc, int fr, int fq, const LAS float* biasL) const {
        const int row0 = u.pm * BM + wr * 64 + fr; const int cl = wc * 32 + 8 * fq; const int col0 = u.pn * BM + cl;
        f32x4 bv[2][2];
#pragma unroll
        for (int bj = 0; bj < 2; ++bj)
#pragma unroll
            for (int n = 0; n < 2; ++n) bv[bj][n] = bias ? *(const LAS f32x4*)(biasL + cl + bj * HALF + 4 * n) : (f32x4){0.f, 0.f, 0.f, 0.f};
#pragma unroll
        for (int ai = 0; ai < 2; ++ai)
#pragma unroll
            for (int m = 0; m < 4; ++m) { bf16_t* rowp = O + (size_t)(row0 + ai * HALF + m * 16) * ldc + col0;
#pragma unroll
                for (int bj = 0; bj < 2; ++bj) { const f32x4 v0 = acc[ai][bj][m][0] * ascale + bv[bj][0], v1 = acc[ai][bj][m][1] * ascale + bv[bj][1];
                    u32x4 w; w.x = pk2(v0[0], v0[1]); w.y = pk2(v0[2], v0[3]); w.z = pk2(v1[0], v1[1]); w.w = pk2(v1[2], v1[3]);
                    EPI_ST((u32x4*)(rowp + bj * HALF), w); } }
    }
};
struct EpiResid {
    static constexpr bool PERM = false;
    const float* X; float* Y; float alpha; float ascale;
    DI const float* bias_ptr(const Unit&) const { return nullptr; }
    DI void operator()(const f32x4 (&acc)[2][2][4][2], const Unit& u, int wr, int wc, int fr, int fq, const LAS float*) const {
        const int col0 = u.pn * BM + wc * 32 + 4 * fq;
        const size_t rbase = (size_t)(u.pm * BM + wr * 64 + fr) * DM + col0;
        f32x4 xs[2][2][2][2];
#define RES_LOAD(b_) do { _Pragma("unroll") for (int mm = 0; mm < 2; ++mm) _Pragma("unroll") for (int bj = 0; bj < 2; ++bj) _Pragma("unroll") for (int n = 0; n < 2; ++n) \
            xs[(b_) & 1][mm][bj][n] = *(const f32x4*)(X + rbase + (size_t)(((b_) >> 1) * HALF + (2 * ((b_) & 1) + mm) * 16) * DM + bj * HALF + n * 16); } while (0)
        RES_LOAD(0);
#pragma unroll
        for (int b = 0; b < 4; ++b) {
            if (b < 3) RES_LOAD(b + 1);
            __builtin_amdgcn_sched_barrier(0);
#pragma unroll
            for (int mm = 0; mm < 2; ++mm)
#pragma unroll
                for (int bj = 0; bj < 2; ++bj)
#pragma unroll
                    for (int n = 0; n < 2; ++n) EPI_ST((f32x4*)(Y + rbase + (size_t)((b >> 1) * HALF + (2 * (b & 1) + mm) * 16) * DM + bj * HALF + n * 16), xs[b & 1][mm][bj][n] * alpha + acc[b >> 1][bj][2 * (b & 1) + mm][n] * ascale);
            __builtin_amdgcn_sched_barrier(0);
        }
#undef RES_LOAD
    }
};
template <bool OUT8> struct EpiSwiglu {
    static constexpr bool PERM = true;
    void* O; const float* bias; float ascale;
    DI const float* bias_ptr(const Unit& u) const { return bias + (size_t)u.e * 2048 + u.pn * BM; }
    DI void operator()(const f32x4 (&acc)[2][2][4][2], const Unit& u, int wr, int wc, int fr, int fq, const LAS float* biasL) const {
        const int row0 = u.pm * BM + wr * 64 + fr; const int cl = wc * 32 + 8 * fq; const int col0 = u.pn * BM + cl;
        f32x4 bv[2][2];
#pragma unroll
        for (int bj = 0; bj < 2; ++bj)
#pragma unroll
            for (int n = 0; n < 2; ++n) bv[bj][n] = *(const LAS f32x4*)(biasL + cl + bj * HALF + 4 * n);
#pragma unroll
        for (int ai = 0; ai < 2; ++ai)
#pragma unroll
            for (int m = 0; m < 4; ++m) { const size_t eoff = (size_t)(row0 + ai * HALF + m * 16) * DFF + (col0 >> 1);
#pragma unroll
                for (int bj = 0; bj < 2; ++bj) { const f32x4 v0 = acc[ai][bj][m][0] * ascale + bv[bj][0], v1 = acc[ai][bj][m][1] * ascale + bv[bj][1];
                    float a[4];
#pragma unroll
                    for (int k = 0; k < 4; ++k) { const float g = fminf(k < 2 ? v0[2 * k] : v1[2 * k - 4], 7.0f); const float uu = fminf(fmaxf(k < 2 ? v0[2 * k + 1] : v1[2 * k - 3], -7.0f), 7.0f);
                        a[k] = (uu + 1.0f) * (g * sigmoidf_(g * 1.702f)); }
                    if constexpr (OUT8) { EPI_ST((unsigned*)((unsigned char*)O + eoff + bj * (HALF / 2)), pk4_fp8(a[0], a[1], a[2], a[3])); }
                    else { u32x2 w; w.x = pk2(a[0], a[1]); w.y = pk2(a[2], a[3]); EPI_ST((u32x2*)((bf16_t*)O + eoff + bj * (HALF / 2)), w); } } }
    }
};
struct EpiPle {
    static constexpr bool PERM = true;
    bf16_t* O; const bf16_t* PP; const float* bias; float ascale;
    DI const float* bias_ptr(const Unit& u) const { return bias + u.pn * BM; }
    DI void operator()(const f32x4 (&acc)[2][2][4][2], const Unit& u, int wr, int wc, int fr, int fq, const LAS float* biasL) const {
        const int row0 = u.pm * BM + wr * 64 + fr; const int cl = wc * 32 + 8 * fq; const int col0 = u.pn * BM + cl;
        f32x4 bv[2][2];
#pragma unroll
        for (int bj = 0; bj < 2; ++bj)
#pragma unroll
            for (int n = 0; n < 2; ++n) bv[bj][n] = *(const LAS f32x4*)(biasL + cl + bj * HALF + 4 * n);
        u32x4 ppv[2][2][2];
#define PLE_LOAD(b_) do { _Pragma("unroll") for (int mm = 0; mm < 2; ++mm) _Pragma("unroll") for (int bj = 0; bj < 2; ++bj) \
            ppv[(b_) & 1][mm][bj] = *(const u32x4*)(PP + (size_t)(row0 + ((b_) >> 1) * HALF + (2 * ((b_) & 1) + mm) * 16) * DM + col0 + bj * HALF); } while (0)
        PLE_LOAD(0);
#pragma unroll
        for (int b = 0; b < 4; ++b) {
            if (b < 3) PLE_LOAD(b + 1);
            __builtin_amdgcn_sched_barrier(0);
#pragma unroll
            for (int mm = 0; mm < 2; ++mm) { const int ai = b >> 1, m = 2 * (b & 1) + mm; const size_t off = (size_t)(row0 + ai * HALF + m * 16) * DM + col0;
#pragma unroll
                for (int bj = 0; bj < 2; ++bj) { const f32x4 v0 = acc[ai][bj][m][0] * ascale + bv[bj][0], v1 = acc[ai][bj][m][1] * ascale + bv[bj][1];
                    const u32x4 pp = ppv[b & 1][mm][bj];
                    u32x4 w; w.x = pk2(sigmoidf_(v0[0]) * bflo(pp.x), sigmoidf_(v0[1]) * bfhi(pp.x)); w.y = pk2(sigmoidf_(v0[2]) * bflo(pp.y), sigmoidf_(v0[3]) * bfhi(pp.y));
                    w.z = pk2(sigmoidf_(v1[0]) * bflo(pp.z), sigmoidf_(v1[1]) * bfhi(pp.z)); w.w = pk2(sigmoidf_(v1[2]) * bflo(pp.w), sigmoidf_(v1[3]) * bfhi(pp.w));
                    EPI_ST((u32x4*)(O + off + bj * HALF), w); } }
            __builtin_amdgcn_sched_barrier(0);
        }
#undef PLE_LOAD
    }
};

template <class Epi, class Sched, class Gath, bool ALIGN_EPI, bool F8 = false>
DI void gemm_phase(LAS unsigned char* lds, const void* Abase, const void* Bbase, const int K, const Sched& S, const Epi& E, const Gath& G) {
    const int tid = opaque_tid(), wid = rfl(tid >> 6), lane = tid & 63, wr = wid >> 2, wc = wid & 3, fr = lane & 15, fq = lane >> 4;
    const int PB = F8 ? K : 2 * K;
    const int nt = PB / 128;
    unsigned voffA[2], voffB[2];
#pragma unroll
    for (int i = 0; i < 2; ++i) { int R, C; stage_rc(tid * 16 + i * 8192, R, C); const int Rb = Epi::PERM ? ((R & ~31) + perm32(R & 31)) : R;
        voffA[i] = (unsigned)(R * PB + C * 2); voffB[i] = (unsigned)(Rb * PB + C * 2); }
    const size_t kstep = (size_t)(BK * 2);
    const size_t hstep = (size_t)HALF * PB;
    const size_t tstep = 2 * hstep;
    const unsigned ldsw = (unsigned)wid * 1024u;
    const int aoff = lds_byte(wr * 64 + fr, fq * 8), boff = lds_byte(wc * 32 + fr, fq * 8);
#define PG8_SA(b, h) (((b) * 2 + (h)) * HTB)
#define PG8_SB(b, h) ((4 + (b) * 2 + (h)) * HTB)
#define PG8_STAGE(bufoff, gbase, voff) do { _Pragma("unroll") for (int _i = 0; _i < 2; ++_i) \
        __builtin_amdgcn_global_load_lds((const unsigned*)((const char*)(gbase) + (voff)[_i]), (LAS unsigned*)(lds + (bufoff) + ldsw + _i * 8192), 16, 0, 0); } while (0)
#define PG8_STA(bufoff, kptr, h, VG) do { if constexpr (Gath::ON) { PG8_STAGE(bufoff, kptr, VG[h]); } else { PG8_STAGE(bufoff, (kptr) + (h) * hstep, voffA); } } while (0)
#define PG8_LDA(dst, b, h) do { _Pragma("unroll") for (int m = 0; m < 4; ++m) { \
        if constexpr (F8) { dst##8[m] = PG8_CAT8(*(const LAS v4i_t*)(lds + PG8_SA(b, h) + aoff + m * 2048), *(const LAS v4i_t*)(lds + PG8_SA(b, h) + aoff + m * 2048 + 1024)); } \
        else { _Pragma("unroll") for (int k = 0; k < 2; ++k) dst[m][k] = *(const LAS bf16x8*)(lds + PG8_SA(b, h) + aoff + m * 2048 + k * 1024); } } } while (0)
#define PG8_LDB(dst, b, h) do { _Pragma("unroll") for (int n = 0; n < 2; ++n) { \
        if constexpr (F8) { dst##8[n] = PG8_CAT8(*(const LAS v4i_t*)(lds + PG8_SB(b, h) + boff + n * 2048), *(const LAS v4i_t*)(lds + PG8_SB(b, h) + boff + n * 2048 + 1024)); } \
        else { _Pragma("unroll") for (int k = 0; k < 2; ++k) dst[n][k] = *(const LAS bf16x8*)(lds + PG8_SB(b, h) + boff + n * 2048 + k * 1024); } } } while (0)
#define PG8_CAT8(x0, x1) __builtin_shufflevector((x0), (x1), 0, 1, 2, 3, 4, 5, 6, 7)
#define PG8_MMA(ai, bj, At, Bt) do { __builtin_amdgcn_s_setprio(1); _Pragma("unroll") for (int m = 0; m < 4; ++m) _Pragma("unroll") for (int n = 0; n < 2; ++n) { \
        if constexpr (F8) { asm volatile("v_mfma_scale_f32_16x16x128_f8f6f4 %0, %1, %2, %0, %3, %3 op_sel_hi:[0,0,0]" : "+v"(acc[ai][bj][m][n]) : "v"(Bt##8[n]), "v"(At##8[m]), "v"(sc127)); } \
        else { _Pragma("unroll") for (int k = 0; k < 2; ++k) acc[ai][bj][m][n] = __builtin_amdgcn_mfma_f32_16x16x32_bf16(Bt[n][k], At[m][k], acc[ai][bj][m][n], 0, 0, 0); } } __builtin_amdgcn_s_setprio(0); } while (0)
#define PG8_WAIT_V(n) asm volatile("s_waitcnt vmcnt(" #n ")" ::: "memory")
#define PG8_WAIT_L(n) asm volatile("s_waitcnt lgkmcnt(" #n ")" ::: "memory")
#define PG8_BAR __builtin_amdgcn_s_barrier()
#define PG8_SCHED __builtin_amdgcn_sched_barrier(0)
    Unit cur, nxt; int ui = 0; unsigned long long pg_t0 = 0ull, pg_acc = 0ull;
    if (!S.next(0, cur)) return;
    f32x4 acc[2][2][4][2];
#pragma unroll
    for (int a = 0; a < 2; ++a)
#pragma unroll
        for (int b = 0; b < 2; ++b)
#pragma unroll
            for (int m = 0; m < 4; ++m)
#pragma unroll
                for (int n = 0; n < 2; ++n) { acc[a][b][m][n] = (f32x4){0.f, 0.f, 0.f, 0.f}; }
    bf16x8 At[4][2], B0[2][2], B1[2][2]; v8i_t At8[4], B08[2], B18[2]; const int sc127 = 127;
    unsigned vgC[2][2], vgN[2][2];
    LAS unsigned* const gtab = (LAS unsigned*)(lds + 131072 + 10240);
    if constexpr (Gath::ON) {
        unsigned gt[20];
#pragma unroll
        for (int i = 0; i < 20; ++i) { Unit uu; gt[i] = 0u; if (S.next(i, uu) && tid < 256) gt[i] = G.tok(uu, tid) * (unsigned)PB; }
#pragma unroll
        for (int i = 0; i < 20; ++i) if (tid < 256) gtab[i * 256 + tid] = gt[i];
        __syncthreads();
    }
#define PG8_GOFF(dst, unit_) do { _Pragma("unroll") for (int h = 0; h < 2; ++h) _Pragma("unroll") for (int i = 0; i < 2; ++i) { int R_, C_; stage_rc(opaque_tid() * 16 + i * 8192, R_, C_); \
        dst[h][i] = gtab[(unit_) * 256 + h * HALF + R_] + (unsigned)C_ * 2u; } } while (0)
#pragma unroll
    for (int h = 0; h < 2; ++h)
#pragma unroll
        for (int i = 0; i < 2; ++i) { vgC[h][i] = 0u; vgN[h][i] = 0u; }
    if constexpr (Gath::ON) { PG8_GOFF(vgC, 0); }
    const char* cA = Gath::ON ? (const char*)Abase : (const char*)Abase + (size_t)cur.pm * tstep; const char* cB = (const char*)Bbase + (size_t)cur.pb * tstep;
    LAS float* const biasL0 = (LAS float*)(lds + 131072 + 8192);
#define PG8_BIAS_DMA(unit_, slot_) do { const float* bp_ = E.bias_ptr(unit_); if (bp_ != nullptr && wid == 0) \
        __builtin_amdgcn_global_load_lds((const unsigned*)(bp_ + 4 * lane), (LAS unsigned*)(biasL0 + 256 * (slot_)), 16, 0, 0); } while (0)
    PG8_BIAS_DMA(cur, 0);
    PG8_STAGE(PG8_SB(0, 0), cB, voffB); PG8_STAGE(PG8_SB(0, 1), cB + hstep, voffB); PG8_STA(PG8_SA(0, 0), cA, 0, vgC); PG8_STA(PG8_SA(0, 1), cA, 1, vgC);
    if (wr == 1) PG8_BAR;
    PG8_WAIT_V(2); PG8_BAR;
    PG8_STAGE(PG8_SB(1, 0), cB + kstep, voffB); PG8_STA(PG8_SA(1, 0), cA + kstep, 0, vgC); PG8_STAGE(PG8_SB(1, 1), cB + hstep + kstep, voffB);
    PG8_WAIT_V(6); PG8_BAR;
    for (;;) {
        const bool has_next = S.next(ui + 1, nxt);
        const char* nA = has_next ? (Gath::ON ? (const char*)Abase : (const char*)Abase + (size_t)nxt.pm * tstep) : cA; const char* nB = has_next ? (const char*)Bbase + (size_t)nxt.pb * tstep : cB;
        if constexpr (F8 && !Gath::ON && Sched::IS_MOE) { if (PROBE_ID == 40 && blockIdx.x == 0) pg_t0 = __builtin_amdgcn_s_memrealtime(); }
#pragma unroll 1
        for (int t = 0; t < nt; t += 2) {
            const bool last = (t == nt - 2);
            const char* a1 = cA + (size_t)(t + 1) * kstep;
            const char* a2 = last ? nA : cA + (size_t)(t + 2) * kstep; const char* b2 = last ? nB : cB + (size_t)(t + 2) * kstep;
            const char* a3 = a2 + kstep; const char* b3 = b2 + kstep;
            unsigned vs[2][2];
#pragma unroll
            for (int h = 0; h < 2; ++h)
#pragma unroll
                for (int i = 0; i < 2; ++i) vs[h][i] = vgC[h][i];
            if constexpr (Gath::ON) { if (last && has_next) { PG8_GOFF(vs, ui + 1); } }
            PG8_LDB(B0, 0, 0); PG8_LDB(B1, 0, 1); PG8_SCHED; PG8_LDA(At, 0, 0); PG8_STA(PG8_SA(1, 1), a1, 1, vgC);
            PG8_WAIT_V(8); PG8_WAIT_L(0); PG8_BAR; PG8_MMA(0, 0, At, B0); PG8_MMA(0, 1, At, B1); PG8_BAR; PG8_SCHED;
            PG8_LDA(At, 0, 1); PG8_STAGE(PG8_SB(0, 0), b2, voffB); PG8_STAGE(PG8_SB(0, 1), b2 + hstep, voffB); PG8_STA(PG8_SA(0, 0), a2, 0, vs);
            PG8_WAIT_V(8); PG8_WAIT_L(0); PG8_BAR; PG8_MMA(1, 0, At, B0); PG8_MMA(1, 1, At, B1); PG8_BAR; PG8_SCHED;
            PG8_LDB(B0, 1, 0); PG8_LDB(B1, 1, 1); PG8_SCHED; PG8_LDA(At, 1, 0); PG8_STA(PG8_SA(0, 1), a2, 1, vs);
            PG8_WAIT_V(8); PG8_WAIT_L(0); PG8_BAR; PG8_MMA(0, 0, At, B0); PG8_MMA(0, 1, At, B1); PG8_BAR; PG8_SCHED;
            PG8_LDA(At, 1, 1); PG8_STAGE(PG8_SB(1, 0), b3, voffB); PG8_STAGE(PG8_SB(1, 1), b3 + hstep, voffB); PG8_STA(PG8_SA(1, 0), a3, 0, vs);
            PG8_WAIT_V(8); PG8_WAIT_L(0); PG8_BAR; PG8_MMA(1, 0, At, B0); PG8_MMA(1, 1, At, B1); PG8_BAR; PG8_SCHED;
        }
        if constexpr (F8 && !Gath::ON && Sched::IS_MOE) { if (PROBE_ID == 40 && blockIdx.x == 0) pg_acc += __builtin_amdgcn_s_memrealtime() - pg_t0; if (PROBE_ID == 41 && blockIdx.x == 0) pg_t0 = __builtin_amdgcn_s_memrealtime(); }
        if constexpr (ALIGN_EPI) { if (wr == 0) PG8_BAR; }
        if constexpr (F8) { asm volatile("s_nop 15\n\ts_nop 15" ::: "memory"); }
        E(acc, cur, wr, wc, fr, fq, biasL0 + 256 * (ui & 1));
        if constexpr (F8 && !Gath::ON && Sched::IS_MOE) { if (PROBE_ID == 41 && blockIdx.x == 0) { asm volatile("s_waitcnt vmcnt(0)" ::: "memory"); pg_acc += __builtin_amdgcn_s_memrealtime() - pg_t0; } }
        if (!has_next) break;
#pragma unroll
        for (int a = 0; a < 2; ++a)
#pragma unroll
            for (int b = 0; b < 2; ++b)
#pragma unroll
                for (int m = 0; m < 4; ++m)
#pragma unroll
                    for (int n = 0; n < 2; ++n) { acc[a][b][m][n] = (f32x4){0.f, 0.f, 0.f, 0.f}; }
        cur = nxt; cA = nA; cB = nB; ++ui;
        PG8_BIAS_DMA(cur, ui & 1);
        if constexpr (Gath::ON) { PG8_GOFF(vgC, ui); }
        if constexpr (ALIGN_EPI) { if (wr == 1) PG8_BAR; }
    }
    PG8_WAIT_V(0);
    if constexpr (!ALIGN_EPI) { if (wr == 0) PG8_BAR; }
    PG8_BAR;
    if constexpr (F8 && !Gath::ON && Sched::IS_MOE) { if ((PROBE_ID == 40 || PROBE_ID == 41) && blockIdx.x == 0 && tid == 0) { volatile LAS unsigned long long* pa = (volatile LAS unsigned long long*)(lds + 131072 + 72 * 4); *pa = *pa + pg_acc; } }
#undef PG8_SA
#undef PG8_SB
#undef PG8_STAGE
#undef PG8_STA
#undef PG8_LDA
#undef PG8_LDB
#undef PG8_MMA
#undef PG8_BIAS_DMA
#undef PG8_GOFF
#undef PG8_CAT8
#undef PG8_WAIT_V
#undef PG8_WAIT_L
#undef PG8_BAR
#undef PG8_SCHED
}
}

typedef GAS unsigned gu32;
#define RLX_AGENT __ATOMIC_RELAXED, __HIP_MEMORY_SCOPE_AGENT
#define XB_TMO      128
#define XB_XCNT(j)  (256  + 64 * (j))
#define XB_XSUB(j)  (1280 + 64 * (j))
#define XB_XGEN(j)  (2304 + 64 * (j))
#define XB_TOP      3328
#define XB_TOPGEN   3392
#define XCD_BAR_WORDS 3456
#define XB_SPIN_CAP (1u << 18)
DI unsigned xb_ld(unsigned* p)              { return __hip_atomic_load(p, __ATOMIC_RELAXED, __HIP_MEMORY_SCOPE_AGENT); }
DI unsigned xb_add(unsigned* p, unsigned v) { return __hip_atomic_fetch_add(p, v, __ATOMIC_RELAXED, __HIP_MEMORY_SCOPE_AGENT); }
DI unsigned xb_xcc_id() { return (unsigned)__builtin_amdgcn_s_getreg((3 << 11) | 20) & 0xFu; }
#define XB_SPIN(cond, bar) do { unsigned _sp = 0; while (cond) { __builtin_amdgcn_s_sleep(1); \
    if ((++_sp & 255u) == 0u) { if (xb_ld(&(bar)[XB_TMO])) break; if (_sp > XB_SPIN_CAP) { atomicAdd(&(bar)[XB_TMO], 1u); break; } } } } while (0)
struct XcdBarrier { unsigned* bar; unsigned x; volatile LAS unsigned* st; };
DI XcdBarrier xcd_barrier_post(unsigned* bar, volatile LAS unsigned* st) {
    XcdBarrier b; b.bar = bar; b.x = xb_xcc_id(); b.st = st;
    if (threadIdx.x == 0) (void)xb_add(&bar[XB_XCNT(b.x)], 1u);
    return b;
}
DI void xcd_barrier_complete(unsigned* bar, unsigned x, unsigned& nloc, unsigned& nx) {
    const unsigned G = gridDim.x * gridDim.y * gridDim.z;
    unsigned sum, cnt, mine, sp = 0u;
    for (;;) {
        sum = 0u; cnt = 0u; mine = 0u;
#pragma unroll
        for (unsigned j = 0; j < 16; ++j) { const unsigned c = xb_ld(&bar[XB_XCNT(j)]); sum += c; cnt += (c > 0u) ? 1u : 0u; mine = (j == x) ? c : mine; }
        if (sum == G) break;
        __builtin_amdgcn_s_sleep(1);
        if ((++sp & 255u) == 0u) { if (xb_ld(&bar[XB_TMO])) break; if (sp > XB_SPIN_CAP) { atomicAdd(&bar[XB_TMO], 1u); break; } }
    }
    nloc = mine > 0u ? mine : 1u; nx = cnt > 0u ? cnt : 1u;
}
DI void xcd_barrier(const XcdBarrier& b) {
    asm volatile("s_waitcnt vmcnt(0)" ::: "memory");
    __syncthreads();
    if (threadIdx.x == 0) {
        unsigned* bar = b.bar;
        __builtin_amdgcn_s_waitcnt(0);
        unsigned nloc = b.st[0], nx = b.st[1];
        if (nloc == 0u) { xcd_barrier_complete(bar, b.x, nloc, nx); b.st[0] = nloc; b.st[1] = nx; }
        const unsigned old = xb_add(&bar[XB_XSUB(b.x)], 1u);
        const unsigned gen = old / nloc;
        if (old + 1u == (gen + 1u) * nloc) {
            __builtin_amdgcn_fence(__ATOMIC_RELEASE, "agent");
            asm volatile("s_waitcnt vmcnt(0)" ::: "memory");
            const unsigned og = xb_add(&bar[XB_TOP], 1u);
            const unsigned tg = og / nx;
            if (og + 1u == (tg + 1u) * nx) xb_add(&bar[XB_TOPGEN], 1u);
            else XB_SPIN(xb_ld(&bar[XB_TOPGEN]) == tg, bar);
            __builtin_amdgcn_fence(__ATOMIC_ACQUIRE, "agent");
            xb_add(&bar[XB_XGEN(b.x)], 1u);
            asm volatile("s_waitcnt vmcnt(0)" ::: "memory");
        } else {
            XB_SPIN(xb_ld(&bar[XB_XGEN(b.x)]) == gen, bar);
            __builtin_amdgcn_fence(__ATOMIC_ACQUIRE, "agent");
            asm volatile("s_waitcnt vmcnt(0)" ::: "memory");
        }
    }
    __syncthreads();
}

struct Args {
    const float* in[23]; float* out; unsigned char* ws; int ph_lo, ph_hi;
};
struct Ctx {
    LAS unsigned char* lds; volatile LAS unsigned* MISC; unsigned* ctl; unsigned char* ws;
    int tid, lane, wave, G, blk;
};
DI Ctx make_ctx(LAS unsigned char* lds, unsigned char* ws, int G, int blk) {
    Ctx X; X.lds = lds; X.MISC = (volatile LAS unsigned*)(lds + 131072); X.ws = ws; X.ctl = (unsigned*)ws;
    X.tid = opaque_tid(); X.lane = X.tid & 63; X.wave = __builtin_amdgcn_readfirstlane(X.tid >> 6); X.G = G; X.blk = blk; return X;
}

#define MFMA32(a, b, c) __builtin_amdgcn_mfma_f32_32x32x16_bf16((a), (b), (c), 0, 0, 0)
DI int crow(int reg, int h) { return (reg & 3) + 8 * (reg >> 2) + 4 * h; }
DI s16x4 tr16(const LAS unsigned char* p) { return __builtin_bit_cast(s16x4, __builtin_amdgcn_ds_read_tr16_b64_v4i16((LAS v4i16_t*)p)); }
DI bf16x8 frag_tr(const LAS unsigned char* img, int pitch, int k_lo, int k_hi, int m0, int lane) {
    const int i16 = lane & 15, q = i16 >> 2, p = i16 & 3, blk = (lane >> 4) & 1;
    const LAS unsigned char* a = img + (m0 + 16 * blk + 4 * p) * 2;
    const s16x4 lo = tr16(a + (k_lo + q) * pitch), hi = tr16(a + (k_hi + q) * pitch);
    return __builtin_shufflevector(lo, hi, 0, 1, 2, 3, 4, 5, 6, 7);
}
DI bf16x8 frag_row(const LAS unsigned char* img, int pitch, int row, int kbyte) { return *(const LAS bf16x8*)(img + row * pitch + kbyte); }
template <int s> DI bf16x8 pack8(const f32x16& x) {
    u32x4 p; p.x = pk2(x[8 * s], x[8 * s + 1]); p.y = pk2(x[8 * s + 2], x[8 * s + 3]); p.z = pk2(x[8 * s + 4], x[8 * s + 5]); p.w = pk2(x[8 * s + 6], x[8 * s + 7]);
    return __builtin_bit_cast(bf16x8, p);
}
DI f32x16 zero16() { f32x16 z;
#pragma unroll
    for (int i = 0; i < 16; ++i) z[i] = 0.f;
    return z; }
DI f32x16 splat16(float v) { f32x16 z;
#pragma unroll
    for (int i = 0; i < 16; ++i) z[i] = v;
    return z; }

template <int CTRL> DI float dppf(float v) { return __int_as_float(__builtin_amdgcn_update_dpp(0, __float_as_int(v), CTRL, 0xf, 0xf, false)); }
DI float swap16_sum(float a, float b) { const auto rr = __builtin_amdgcn_permlane16_swap(__float_as_uint(a), __float_as_uint(b), false, false); return __uint_as_float(rr[0]) + __uint_as_float(rr[1]); }
DI float swap32_sum(float a, float b) { const auto rr = __builtin_amdgcn_permlane32_swap(__float_as_uint(a), __float_as_uint(b), false, false); return __uint_as_float(rr[0]) + __uint_as_float(rr[1]); }
DI float wave_allsum(float v) {
    v += dppf<0xB1>(v); v += dppf<0x4E>(v); v += dppf<0x141>(v); v += dppf<0x140>(v);
    v = swap16_sum(v, v); v = swap32_sum(v, v); return v;
}
template <int CTRL, int RM> DI float dppz(float v) { return __int_as_float(__builtin_amdgcn_update_dpp(0, __float_as_int(v), CTRL, RM, 0xf, false)); }
DI float wave_incl_scan(float v) {
    v += dppz<0x111, 0xf>(v); v += dppz<0x112, 0xf>(v); v += dppz<0x114, 0xf>(v); v += dppz<0x118, 0xf>(v);
    v += dppz<0x142, 0xa>(v); v += dppz<0x143, 0xc>(v); return v;
}
DI void transpose_item(const float* W, int K, int srcN, bf16_t* WT, int k0, int n0dst, int scol, int nvalid, LAS float* scr, int lane) {
    const int cl = lane & 31; const bool ok = cl < nvalid;
    float tv[32];
    const float* src = W + (size_t)(k0 + (lane >> 5)) * srcN + scol + cl;
#pragma unroll
    for (int i = 0; i < 32; ++i) tv[i] = ok ? __builtin_nontemporal_load(src + (size_t)(2 * i) * srcN) : 0.f;
#pragma unroll
    for (int i = 0; i < 32; ++i) scr[(2 * i + (lane >> 5)) * 33 + cl] = tv[i];
    asm volatile("s_waitcnt lgkmcnt(0)" ::: "memory");
    const int c = lane & 7;
#pragma unroll
    for (int j = 0; j < 4; ++j) { const int n = (lane >> 3) + 8 * j; const LAS float* s = scr + (8 * c) * 33 + n;
        u32x4 o; o.x = pk2(s[0 * 33], s[1 * 33]); o.y = pk2(s[2 * 33], s[3 * 33]); o.z = pk2(s[4 * 33], s[5 * 33]); o.w = pk2(s[6 * 33], s[7 * 33]);
        *(u32x4*)(WT + (size_t)(n0dst + n) * K + k0 + 8 * c) = o; }
    asm volatile("s_waitcnt lgkmcnt(0)" ::: "memory");
}
DI void transpose_item_f8(const float* W, int K, int srcN, unsigned char* WT, int k0, int n0dst, int scol, int nvalid, float wscale, LAS float* scr, int lane) {
    const int cl = lane & 31; const bool ok = cl < nvalid;
    float tv[32];
    const float* src = W + (size_t)(k0 + (lane >> 5)) * srcN + scol + cl;
#pragma unroll
    for (int i = 0; i < 32; ++i) tv[i] = ok ? __builtin_nontemporal_load(src + (size_t)(2 * i) * srcN) : 0.f;
#pragma unroll
    for (int i = 0; i < 32; ++i) scr[(2 * i + (lane >> 5)) * 33 + cl] = tv[i] * wscale;
    asm volatile("s_waitcnt lgkmcnt(0)" ::: "memory");
    const int c = lane & 7;
#pragma unroll
    for (int j = 0; j < 4; ++j) { const int n = (lane >> 3) + 8 * j; const LAS float* sp = scr + (8 * c) * 33 + n;
        u32x2 o; o.x = pk4_fp8(sp[0 * 33], sp[1 * 33], sp[2 * 33], sp[3 * 33]); o.y = pk4_fp8(sp[4 * 33], sp[5 * 33], sp[6 * 33], sp[7 * 33]);
        *(u32x2*)(WT + (size_t)(n0dst + n) * K + k0 + 8 * c) = o; }
    asm volatile("s_waitcnt lgkmcnt(0)" ::: "memory");
}
DI void transpose_batch(Ctx& X, const float* W, bf16_t* WT, int nmat, int K, int N, int gw, int NGW, LAS float* scr) {
    const int nb = N / 32, per = (K / 64) * nb; const long total = (long)nmat * per;
    for (long it = gw; it < total; it += NGW) { const int mat = (int)(it / per), r = (int)(it % per), kb = r / nb, nbk = r % nb;
        transpose_item(W + (size_t)mat * K * N, K, N, WT + (size_t)mat * K * N, 64 * kb, 32 * nbk, 32 * nbk, 32, scr, X.lane); }
}
DI void transpose_batch_f8(Ctx& X, const float* W, unsigned char* WT, int nmat, int K, int N, float wscale, int gw, int NGW, LAS float* scr) {
    const int nb = N / 32, per = (K / 64) * nb; const long total = (long)nmat * per;
    for (long it = gw; it < total; it += NGW) { const int mat = (int)(it / per), r = (int)(it % per), kb = r / nb, nbk = r % nb;
        transpose_item_f8(W + (size_t)mat * K * N, K, N, WT + (size_t)mat * K * N, 64 * kb, 32 * nbk, 32 * nbk, 32, wscale, scr, X.lane); }
}
NI void ph_p0(LAS unsigned char* lds_, unsigned char* ws_, const float* x_, const float* p_, const float* w_in_, const float* w_out_, const float* w_gu_, const float* w_dn_, const float* w_pg_, const float* w_pp_, int G_, int blk_) {
    Ctx X = make_ctx(lds_, uni(ws_), rfl(G_), rfl(blk_));
    const float* const in0 = uni(x_); const float* const in1 = uni(p_); const float* const in2 = uni(w_in_); const float* const in8 = uni(w_out_);
    const float* const in14 = uni(w_gu_); const float* const in16 = uni(w_dn_); const float* const in18 = uni(w_pg_); const float* const in20 = uni(w_pp_);
    LAS float* scr = (LAS float*)(X.lds + X.wave * 16384);
    const int gw = X.blk * 8 + X.wave, NGW = X.G * 8;
    unsigned char* ws = X.ws;
    { const int nb = ZW / 32, per = 16 * nb; const long total = (long)DEPTH * per;
      for (long it = gw; it < total; it += NGW) { const int mat = (int)(it / per), r = (int)(it % per), kb = r / nb, nbk = r % nb, n0 = 32 * nbk;
          int scol, nv; if (n0 < 512) { scol = n0; nv = 32; } else if (n0 < 3328) { scol = n0 + 16; nv = 32; } else if (n0 == 3328) { scol = 512; nv = 16; } else { scol = 0; nv = 0; }
#if F8_IN
          transpose_item_f8(in2 + (size_t)mat * DM * INW, DM, INW, ws + WS_WIN + (size_t)mat * ZW * DM, 64 * kb, n0, scol, nv, 32.0f, scr, X.lane); } }
#else
          transpose_item(in2 + (size_t)mat * DM * INW, DM, INW, (bf16_t*)(ws + WS_WIN) + (size_t)mat * ZW * DM, 64 * kb, n0, scol, nv, scr, X.lane); } }
#endif
#if F8_OUT
    transpose_batch_f8(X, in8, ws + WS_WOUT, DEPTH, DM, DM, 32.0f, gw, NGW, scr);
#else
    transpose_batch(X, in8, (bf16_t*)(ws + WS_WOUT), DEPTH, DM, DM, gw, NGW, scr);
#endif
#if F8_PG
    transpose_batch_f8(X, in18, ws + WS_WPG, DEPTH, DM, DM, 32.0f, gw, NGW, scr);
#else
    transpose_batch(X, in18, (bf16_t*)(ws + WS_WPG), DEPTH, DM, DM, gw, NGW, scr);
#endif
    transpose_batch(X, in20, (bf16_t*)(ws + WS_WPP), DEPTH, PLE, DM, gw, NGW, scr);
#if F8_MOE
    transpose_batch_f8(X, in14, ws + WS_WGU, DEPTH * NEXP, DM, 2 * DFF, 32.0f, gw, NGW, scr);
    transpose_batch_f8(X, in16, ws + WS_WDN, DEPTH * NEXP, DFF, DM, 32.0f, gw, NGW, scr);
#else
    transpose_batch(X, in14, (bf16_t*)(ws + WS_WGU), DEPTH * NEXP, DM, 2 * DFF, gw, NGW, scr);
    transpose_batch(X, in16, (bf16_t*)(ws + WS_WDN), DEPTH * NEXP, DFF, DM, gw, NGW, scr);
#endif
    const long gt = (long)X.blk * 512 + X.tid, NGT = (long)X.G * 512;
#define CVT_STREAM(SRC, DST, N8) do { const f32x4* src = (const f32x4*)(SRC); u32x4* dst = (u32x4*)(DST); const long n8 = (N8); \
      for (long i = gt; i < n8; i += 4 * NGT) { f32x4 a[4], b[4]; \
          _Pragma("unroll") for (int u = 0; u < 4; ++u) { const long ii = i + u * NGT; if (ii < n8) { a[u] = __builtin_nontemporal_load(src + 2 * ii); b[u] = __builtin_nontemporal_load(src + 2 * ii + 1); } } \
          _Pragma("unroll") for (int u = 0; u < 4; ++u) { const long ii = i + u * NGT; if (ii < n8) { u32x4 o; o.x = pk2(a[u][0], a[u][1]); o.y = pk2(a[u][2], a[u][3]); o.z = pk2(b[u][0], b[u][1]); o.w = pk2(b[u][2], b[u][3]); dst[ii] = o; } } } } while (0)
#if F8_IN
    { const f32x4* src = (const f32x4*)in0; u32x2* dst = (u32x2*)(ws + WS_XB); const long n8 = (long)NTOK * DM / 8;
      for (long i = gt; i < n8; i += NGT) { const f32x4 a = __builtin_nontemporal_load(src + 2 * i), b = __builtin_nontemporal_load(src + 2 * i + 1); u32x2 o; o.x = pk4_fp8(a[0], a[1], a[2], a[3]); o.y = pk4_fp8(b[0], b[1], b[2], b[3]); dst[i] = o; } }
#else
    CVT_STREAM(in0, ws + WS_XB, (long)NTOK * DM / 8);
#endif
    CVT_STREAM(in1, ws + WS_PB, (long)DEPTH * NTOK * PLE / 8);
#undef CVT_STREAM
    { f32x2* sc = (f32x2*)(ws + WS_SINCOS);
      for (long i = gt; i < (long)SEQ * 32; i += NGT) { const int t = (int)(i >> 5), j = (int)(i & 31); const double rev = (double)t * kThetaRev[j]; const float fr = (float)(rev - __builtin_floor(rev));
          sc[i] = (f32x2){__builtin_amdgcn_sinf(fr), __builtin_amdgcn_cosf(fr)}; } }
}

constexpr int AT_KP = 272, AT_VP = 320, AT_KB = 64 * AT_KP, AT_VB = 64 * AT_VP;
constexpr int AT_BIAS_OFF = 122880;
NI void attn_unit(LAS unsigned char* lds, const bf16_t* z_, bf16_t* mixed_, int b_, int h_, int qb_, float lam_, float outscale_, const float* normg_, unsigned long long& tp_t0, unsigned long long& tp_acc) {
    const bf16_t* const z = uni(z_); bf16_t* const mixed = uni(mixed_); const int b = rfl(b_), h = rfl(h_), qb = rfl(qb_); const float lam = unif(lam_), outscale = unif(outscale_); const float* const normg = uni(normg_);
    const int tid = opaque_tid(), lane = tid & 63, w = rfl(tid >> 6), r = lane & 31, hh = lane >> 5;
    const int map = w & 1, qsub = w >> 1;
    const int q0 = qb * 128;
    const size_t rowbase = (size_t)b * SEQ;
    const int NT = (q0 + 128) / 64;
    const LAS float* biasT = (const LAS float*)(lds + AT_BIAS_OFF) + h * 128;
    const int qpos = q0 + 32 * qsub + r;
    const float C2 = 0.125f * LOG2E;
    bf16x8 qf[4];
    { const bf16_t* qrow = z + (rowbase + qpos) * ZW + ZC_DQ + h * 128 + map * 64 + 8 * hh;
#pragma unroll
      for (int ds = 0; ds < 4; ++ds) { u32x4 raw = *(const u32x4*)(qrow + 16 * ds);
          raw.x = pk2(bflo(raw.x) * C2, bfhi(raw.x) * C2); raw.y = pk2(bflo(raw.y) * C2, bfhi(raw.y) * C2); raw.z = pk2(bflo(raw.z) * C2, bfhi(raw.z) * C2); raw.w = pk2(bflo(raw.w) * C2, bfhi(raw.w) * C2);
          qf[ds] = __builtin_bit_cast(bf16x8, raw); } }
    const bf16_t* kg = z + (rowbase + (tid >> 4)) * ZW + ZC_DK + h * 128 + (tid & 15) * 8;
    const bf16_t* vg = z + (rowbase + (tid >> 4)) * ZW + ZC_DV + h * 128 + (tid & 15) * 8;
    const int kdst = (tid >> 4) * AT_KP + (tid & 15) * 16, vdst = 2 * AT_KB + (tid >> 4) * AT_VP + (tid & 15) * 16;
    const bool typeB = (w >= 4);
    u32x4 kr0, kr1, vr0, vr1;
    kr0 = *(const u32x4*)(kg); kr1 = *(const u32x4*)(kg + (size_t)32 * ZW); vr0 = *(const u32x4*)(vg); vr1 = *(const u32x4*)(vg + (size_t)32 * ZW);
    *(LAS u32x4*)(lds + kdst) = kr0; *(LAS u32x4*)(lds + kdst + 32 * AT_KP) = kr1; *(LAS u32x4*)(lds + vdst) = vr0; *(LAS u32x4*)(lds + vdst + 32 * AT_VP) = vr1;
    __syncthreads();
    f32x16 O[4];
#pragma unroll
    for (int et = 0; et < 4; ++et) O[et] = zero16();
    float m_run = 0.f, l_run = 0.f;
    const float bias_far = biasT[127];
    float nm = bias_far;
    bf16x8 pq0, pq1, pq2, pq3; bool prev_active = false; int vs_cur = 0, vs_prev = 0;
    pq0 = pq1 = pq2 = pq3 = (bf16x8){0, 0, 0, 0, 0, 0, 0, 0};
#define ATT_MFMA_T(acc_, a_, b_) acc_ = MFMA32((a_), (b_), acc_)
#define ATT_PV(Vb_, q0_, q1_, q2_, q3_) do { bf16x8 vf[4]; \
        _Pragma("unroll") for (int et = 0; et < 4; ++et) { \
            _Pragma("unroll") for (int ks = 0; ks < 4; ++ks) vf[ks] = frag_tr((Vb_), AT_VP, 16 * ks + 4 * hh, 16 * ks + 8 + 4 * hh, 32 * et, lane); \
            __builtin_amdgcn_sched_barrier(0); \
            ATT_MFMA_T(O[et], vf[0], (q0_)); ATT_MFMA_T(O[et], vf[1], (q1_)); \
            ATT_MFMA_T(O[et], vf[2], (q2_)); ATT_MFMA_T(O[et], vf[3], (q3_)); \
            __builtin_amdgcn_sched_barrier(0); } } while (0)
#define ATT_LOOP(TB) do { \
    for (int t = 0; t < NT; ++t) { \
        const bool more = (t + 1 < NT); \
        if ((TB) && prev_active) ATT_PV(lds + 2 * AT_KB + vs_prev * AT_VB, pq0, pq1, pq2, pq3); \
        if (more) { const size_t go = (size_t)(t + 1) * 64 * ZW; kr0 = *(const u32x4*)(kg + go); kr1 = *(const u32x4*)(kg + go + (size_t)32 * ZW); vr0 = *(const u32x4*)(vg + go); vr1 = *(const u32x4*)(vg + go + (size_t)32 * ZW); } \
        const bool active = (64 * t <= q0 + 32 * qsub + 31); \
        if (active) { \
            const LAS unsigned char* Kb = lds + (t & 1) * AT_KB; const LAS unsigned char* Vb = lds + 2 * AT_KB + vs_cur * AT_VB; \
            const bool near = (t >= NT - 4); \
            f32x16 p0, p1; \
            { bf16x8 ka[4][2]; \
_Pragma("unroll") \
              for (int ds = 0; ds < 4; ++ds) { const int kbyte = (map * 64 + 16 * ds + 8 * hh) * 2; ka[ds][0] = frag_row(Kb, AT_KP, r, kbyte); ka[ds][1] = frag_row(Kb, AT_KP, 32 + r, kbyte); } \
              __builtin_amdgcn_sched_barrier(0); \
              p0 = splat16(nm); p1 = p0; \
_Pragma("unroll") \
              for (int ds = 0; ds < 4; ++ds) { p0 = MFMA32(ka[ds][0], qf[ds], p0); p1 = MFMA32(ka[ds][1], qf[ds], p1); } } \
            if (near) { \
                asm volatile("" ::: "memory"); \
                float b0[16], b1[16]; \
_Pragma("unroll") \
                for (int reg = 0; reg < 16; ++reg) { const int n0 = qpos - (64 * t + crow(reg, hh)), n1 = n0 - 32; \
                    b0[reg] = biasT[n0 > 127 ? 127 : (n0 < 0 ? 0 : n0)]; b1[reg] = biasT[n1 > 127 ? 127 : (n1 < 0 ? 0 : n1)]; } \
_Pragma("unroll") \
                for (int reg = 0; reg < 16; ++reg) { const int n0 = qpos - (64 * t + crow(reg, hh)), n1 = n0 - 32; \
                    p0[reg] = n0 < 0 ? -1e30f : p0[reg] + (b0[reg] - bias_far); \
                    p1[reg] = n1 < 0 ? -1e30f : p1[reg] + (b1[reg] - bias_far); } \
            } \
            float mx = fmaxf(p0[0], p1[0]); \
_Pragma("unroll") \
            for (int reg = 1; reg < 16; ++reg) mx = fmaxf(fmaxf(mx, p0[reg]), p1[reg]); \
            { const auto rr = __builtin_amdgcn_permlane32_swap(__float_as_uint(mx), __float_as_uint(mx), false, false); mx = fmaxf(__uint_as_float(rr[0]), __uint_as_float(rr[1])); } \
            if (t == 0 || !__all(mx <= 8.0f)) { \
                asm volatile("" ::: "memory"); \
                const float delta = (t == 0) ? mx : fmaxf(mx, 0.f); \
                m_run += delta; const float sc = __builtin_amdgcn_exp2f(-delta); \
                l_run *= sc; \
_Pragma("unroll") \
                for (int et = 0; et < 4; ++et) O[et] = O[et] * sc; \
                nm -= delta; \
_Pragma("unroll") \
                for (int reg = 0; reg < 16; ++reg) { p0[reg] -= delta; p1[reg] -= delta; } \
            } \
            f32x2 ps2 = {0.f, 0.f}; \
_Pragma("unroll") \
            for (int reg = 0; reg < 16; ++reg) { p0[reg] = __builtin_amdgcn_exp2f(p0[reg]); p1[reg] = __builtin_amdgcn_exp2f(p1[reg]); ps2 = ps2 + (f32x2){p0[reg], p1[reg]}; } \
            l_run += ps2[0] + ps2[1]; \
            const bf16x8 pb00 = pack8<0>(p0), pb01 = pack8<1>(p0), pb10 = pack8<0>(p1), pb11 = pack8<1>(p1); \
            if (!(TB)) ATT_PV(Vb, pb00, pb01, pb10, pb11); \
            else { pq0 = pb00; pq1 = pb01; pq2 = pb10; pq3 = pb11; } \
        } \
        prev_active = active; vs_prev = vs_cur; const int vs_next = (vs_cur == 2) ? 0 : vs_cur + 1; \
        if (PROBE_ID == 28 && blockIdx.x == 64) { asm volatile("s_waitcnt lgkmcnt(0)" ::: "memory"); tp_t0 = __builtin_amdgcn_s_memrealtime(); asm volatile("s_waitcnt lgkmcnt(0)" ::: "memory"); } \
        if (more) { const int bo = ((t + 1) & 1); *(LAS u32x4*)(lds + bo * AT_KB + kdst) = kr0; *(LAS u32x4*)(lds + bo * AT_KB + kdst + 32 * AT_KP) = kr1; \
            *(LAS u32x4*)(lds + vs_next * AT_VB + vdst) = vr0; *(LAS u32x4*)(lds + vs_next * AT_VB + vdst + 32 * AT_VP) = vr1; } \
        vs_cur = vs_next; \
        if (PROBE_ID == 28 && blockIdx.x == 64) { asm volatile("s_waitcnt vmcnt(0) lgkmcnt(0)" ::: "memory"); tp_acc += __builtin_amdgcn_s_memrealtime() - tp_t0; } \
        __syncthreads(); \
    } \
    } while (0)
    if (typeB) ATT_LOOP(1); else ATT_LOOP(0);
#undef ATT_LOOP
    if (typeB && prev_active) ATT_PV(lds + 2 * AT_KB + vs_prev * AT_VB, pq0, pq1, pq2, pq3);
#undef ATT_PV
#undef ATT_MFMA_T
    __syncthreads();

    const float l_tot = swap32_sum(l_run, l_run); const float inv = 1.0f / l_tot;
    LAS float* xch = (LAS float*)lds + qsub * 4096;
    if (map == 1) { const float sc = inv * lam;
#pragma unroll
        for (int et = 0; et < 4; ++et)
#pragma unroll
            for (int reg = 0; reg < 16; ++reg) xch[(et * 16 + reg) * 64 + lane] = O[et][reg] * sc; }
    __syncthreads();
    if (map == 0) { float ss = 0.f;
#pragma unroll
        for (int et = 0; et < 4; ++et)
#pragma unroll
            for (int reg = 0; reg < 16; ++reg) { const float d = O[et][reg] * inv - xch[(et * 16 + reg) * 64 + lane]; O[et][reg] = d; ss += d * d; }
        ss += __shfl_xor(ss, 32);
        const float rn = __builtin_amdgcn_rsqf(ss * (1.0f / 128.0f) + HN_EPS) * outscale;
        bf16_t* orow = mixed + (rowbase + qpos) * DM + 256 + h * 128;
#pragma unroll
        for (int et = 0; et < 4; ++et)
#pragma unroll
            for (int rg = 0; rg < 4; ++rg) { const int e0 = 32 * et + 8 * rg + 4 * hh; const f32x4 g4 = *(const f32x4*)(normg + e0);
#if F8_OUT
                *(unsigned*)((unsigned char*)mixed + (rowbase + qpos) * DM + 256 + h * 128 + e0) = pk4_fp8(O[et][4 * rg] * rn * g4[0], O[et][4 * rg + 1] * rn * g4[1], O[et][4 * rg + 2] * rn * g4[2], O[et][4 * rg + 3] * rn * g4[3]); } }
#else
                u32x2 o; o.x = pk2(O[et][4 * rg] * rn * g4[0], O[et][4 * rg + 1] * rn * g4[1]); o.y = pk2(O[et][4 * rg + 2] * rn * g4[2], O[et][4 * rg + 3] * rn * g4[3]);
                *(u32x2*)(orow + e0) = o; } }
#endif
    __syncthreads();
}

template <int C, int DK, bool GLA>
NI void stream_run(LAS unsigned char* lds, unsigned char* ws_, const float* wg_, const float* bg_, const float* ngain_, int sidx_, int b_, int h_) {
    unsigned char* const ws = uni(ws_); const float* const wgL = uni(wg_); const float* const bgL = uni(bg_); const float* const ngain = uni(ngain_); const int sidx = rfl(sidx_), b = rfl(b_), h = rfl(h_);
    constexpr int PQ = DK * 2 + 16, PV = 192, NC = SEQ / C;
    constexpr int OFF_Q = 0, OFF_K = C * PQ, OFF_V = 2 * C * PQ, OFF_ST = 2 * C * PQ + C * PV, ST_BYTES = 64 * PQ;
    constexpr int NQ = C * DK / 8;
    constexpr int NQK = (2 * NQ) / 512 > 0 ? (2 * NQ) / 512 : 1, NVP = (C * 8) / 512;
    constexpr int NTT = C / 32, NKS = DK / 16;
    const int tid = opaque_tid(), lane = tid & 63, w = rfl(tid >> 6), r = lane & 31, hh = lane >> 5;
    const size_t rowbase = (size_t)b * SEQ;
    const bf16_t* z = (const bf16_t*)(ws + WS_Z);
    bf16_t* mixed = (bf16_t*)(ws + WS_MIX);
    unsigned char* gs = ws + WS_GS + (size_t)sidx * GS_STRIDE;
    bf16_t* QP = (bf16_t*)gs; bf16_t* KP = (bf16_t*)(gs + 512 * 1024); float* DG = (float*)(gs + MiB);
    const int zq = GLA ? ZC_GQ + h * 32 : ZC_RQ + h * 64, zk = GLA ? ZC_GK + h * 32 : ZC_RK + h * 64, zv = GLA ? ZC_GV + h * 64 : ZC_RV + h * 64, zg = GLA ? ZC_GO + h * 64 : ZC_RG + h * 64;
    const int mcol = GLA ? h * 64 : 768 + h * 64;
    const float l2g_tab[4] = {-0.04580368961312479f, -0.02272007650008353f, -0.011315313227834146f, -0.005646563141142063f};
    const float log2g = h == 0 ? l2g_tab[0] : h == 1 ? l2g_tab[1] : h == 2 ? l2g_tab[2] : l2g_tab[3];
    if constexpr (GLA) {
        const float* wg = wgL + h * 32; const float* bg = bgL + h * 32;
        LAS float* wl = (LAS float*)(lds + 65536);
        wl[tid] = wg[(tid >> 5) * 128 + (tid & 31)];
        if (tid < 32) wl[512 + tid] = bg[tid];
        __syncthreads();
        for (int chunk = w; chunk < NC; chunk += 8) {
            const size_t trow = (size_t)chunk * C + lane; const bf16_t* zr = z + (rowbase + trow) * ZW;
            const u32x4 g0 = *(const u32x4*)(zr + ZC_LR), g1 = *(const u32x4*)(zr + ZC_LR + 8);
            u32x4 qv[4], kv[4];
#pragma unroll
            for (int j = 0; j < 4; ++j) { qv[j] = *(const u32x4*)(zr + zq + 8 * j); kv[j] = *(const u32x4*)(zr + zk + 8 * j); }
            const float gl[16] = {bflo(g0.x), bfhi(g0.x), bflo(g0.y), bfhi(g0.y), bflo(g0.z), bfhi(g0.z), bflo(g0.w), bfhi(g0.w),
                                  bflo(g1.x), bfhi(g1.x), bflo(g1.y), bfhi(g1.y), bflo(g1.z), bfhi(g1.z), bflo(g1.w), bfhi(g1.w)};
            u32x4 qo[4], ko[4];
#pragma unroll
            for (int c4 = 0; c4 < 8; ++c4) {
                f32x4 x = *(const LAS f32x4*)(wl + 512 + 4 * c4);
#pragma unroll
                for (int rr = 0; rr < 16; ++rr) x = x + *(const LAS f32x4*)(wl + rr * 32 + 4 * c4) * gl[rr];
                float qn[4], kn[4];
#pragma unroll
                for (int i = 0; i < 4; ++i) {
                    float v = (fminf(x[i], 0.f) - __logf(1.f + __expf(-fabsf(x[i])))) * (1.0f / 16.0f);
#pragma unroll
                    for (int o = 1; o < 64; o <<= 1) { const float tup = __shfl_up(v, o); v += (lane >= o) ? tup : 0.f; }
                    const unsigned qw = qv[c4 >> 1][(c4 & 1) * 2 + (i >> 1)], kw = kv[c4 >> 1][(c4 & 1) * 2 + (i >> 1)];
                    const float qe = (i & 1) ? bfhi(qw) : bflo(qw), ke = (i & 1) ? bfhi(kw) : bflo(kw);
                    const float eq = __expf(v);
                    qn[i] = qe * eq * 0.17677669529663687f; kn[i] = ke * __expf(-v);
                    if (lane == 63) DG[chunk * 32 + 4 * c4 + i] = eq;
                }
                qo[c4 >> 1][(c4 & 1) * 2] = pk2(qn[0], qn[1]); qo[c4 >> 1][(c4 & 1) * 2 + 1] = pk2(qn[2], qn[3]);
                ko[c4 >> 1][(c4 & 1) * 2] = pk2(kn[0], kn[1]); ko[c4 >> 1][(c4 & 1) * 2 + 1] = pk2(kn[2], kn[3]);
            }
#pragma unroll
            for (int j = 0; j < 4; ++j) { *(u32x4*)(QP + trow * DK + 8 * j) = qo[j]; *(u32x4*)(KP + trow * DK + 8 * j) = ko[j]; }
        }
    } else {
        const f32x4* sct = (const f32x4*)(ws + WS_SINCOS);
        for (int it0 = tid; it0 < SEQ * 8; it0 += 4 * 512) {
            u32x4 q4[4], k4[4]; f32x4 s0[4], s1[4];
#pragma unroll
            for (int u = 0; u < 4; ++u) { const int it = it0 + u * 512, t = it >> 3, j = it & 7; const bf16_t* zr = z + (rowbase + t) * ZW;
                q4[u] = *(const u32x4*)(zr + zq + 8 * j); k4[u] = *(const u32x4*)(zr + zk + 8 * j); s0[u] = sct[t * 16 + 2 * j]; s1[u] = sct[t * 16 + 2 * j + 1]; }
#pragma unroll
            for (int u = 0; u < 4; ++u) { const int it = it0 + u * 512, t = it >> 3, j = it & 7;
                const float e = (float)((t & (C - 1)) + 1) * log2g; const float dq = __builtin_amdgcn_exp2f(e), dk = 0.125f * __builtin_amdgcn_exp2f(-e);
                u32x4 qo, ko;
#pragma unroll
                for (int pi = 0; pi < 4; ++pi) { const float sn = pi == 0 ? s0[u][0] : pi == 1 ? s0[u][2] : pi == 2 ? s1[u][0] : s1[u][2], cs = pi == 0 ? s0[u][1] : pi == 1 ? s0[u][3] : pi == 2 ? s1[u][1] : s1[u][3];
                    const float qa = bflo(q4[u][pi]), qb_ = bfhi(q4[u][pi]), ka = bflo(k4[u][pi]), kb_ = bfhi(k4[u][pi]);
                    qo[pi] = pk2((qa * cs - qb_ * sn) * dq, (qb_ * cs + qa * sn) * dq); ko[pi] = pk2((ka * cs - kb_ * sn) * dk, (kb_ * cs + ka * sn) * dk); }
                *(u32x4*)(QP + (size_t)t * DK + 8 * j) = qo; *(u32x4*)(KP + (size_t)t * DK + 8 * j) = ko; }
        }
    }
    for (int i = tid; i < ST_BYTES / 4; i += 512) ((LAS unsigned*)(lds + OFF_ST))[i] = 0u;
    __syncthreads();
    u32x4 rqk[NQK], rv[NVP];
#define ISSUE_LOADS(ci_) do { \
    _Pragma("unroll") for (int j = 0; j < NQK; ++j) { const int idx = tid + 512 * j; \
        if (idx < 2 * NQ) { const bool isk = idx >= NQ; const int id = isk ? idx - NQ : idx; rqk[j] = *(const u32x4*)((isk ? KP : QP) + (size_t)(ci_) * C * DK + (size_t)id * 8); } } \
    _Pragma("unroll") for (int j = 0; j < NVP; ++j) { const int idx = tid + 512 * j, row = idx >> 3, ch = idx & 7; rv[j] = *(const u32x4*)(z + (rowbase + (size_t)(ci_) * C + row) * ZW + zv + ch * 8); } \
    } while (0)
    ISSUE_LOADS(0);
    f32x16 Sacc = zero16();
    const float gC = __builtin_amdgcn_exp2f((float)C * log2g);
    for (int ci = 0; ci < NC; ++ci) {
        __syncthreads();
#pragma unroll
        for (int j = 0; j < NQK; ++j) { const int idx = tid + 512 * j;
            if (idx < 2 * NQ) { const bool isk = idx >= NQ; const int id = isk ? idx - NQ : idx; const int row = id / (DK / 8), ch = id % (DK / 8);
                *(LAS u32x4*)(lds + (isk ? OFF_K : OFF_Q) + row * PQ + ch * 16) = rqk[j]; } }
#pragma unroll
        for (int j = 0; j < NVP; ++j) { const int idx = tid + 512 * j, row = idx >> 3, ch = idx & 7; *(LAS u32x4*)(lds + OFF_V + row * PV + ch * 16) = rv[j]; }
        __syncthreads();
        if (ci + 1 < NC) ISSUE_LOADS(ci + 1);
        const LAS unsigned char* Ql = lds + OFF_Q; const LAS unsigned char* Kl = lds + OFF_K; const LAS unsigned char* Vl = lds + OFF_V;
        const LAS unsigned char* STr = lds + OFF_ST + (ci & 1) * ST_BYTES; LAS unsigned char* STw = lds + OFF_ST + ((ci + 1) & 1) * ST_BYTES;
        if (w < NTT) {
            const int tt = w;
            bf16x8 bq[NKS];
#pragma unroll
            for (int ks = 0; ks < NKS; ++ks) bq[ks] = frag_row(Ql, PQ, 32 * tt + r, (16 * ks + 8 * hh) * 2);
            f32x16 o0 = zero16(), o1 = zero16();
#pragma unroll
            for (int st = 0; st < NTT; ++st) {
                if (st <= tt) {
                    f32x16 Xs = zero16();
#pragma unroll
                    for (int ks = 0; ks < NKS; ++ks) Xs = MFMA32(frag_row(Kl, PQ, 32 * st + r, (16 * ks + 8 * hh) * 2), bq[ks], Xs);
                    if (st == tt) {
#pragma unroll
                        for (int reg = 0; reg < 16; ++reg) if (crow(reg, hh) > r) Xs[reg] = 0.f;
                    }
                    const bf16x8 x0 = pack8<0>(Xs), x1 = pack8<1>(Xs);
                    o0 = MFMA32(frag_tr(Vl, PV, 32 * st + 4 * hh, 32 * st + 8 + 4 * hh, 0, lane), x0, o0);
                    o1 = MFMA32(frag_tr(Vl, PV, 32 * st + 4 * hh, 32 * st + 8 + 4 * hh, 32, lane), x0, o1);
                    o0 = MFMA32(frag_tr(Vl, PV, 32 * st + 16 + 4 * hh, 32 * st + 24 + 4 * hh, 0, lane), x1, o0);
                    o1 = MFMA32(frag_tr(Vl, PV, 32 * st + 16 + 4 * hh, 32 * st + 24 + 4 * hh, 32, lane), x1, o1);
                }
            }
#pragma unroll
            for (int ks = 0; ks < NKS; ++ks) { const int kbyte = (16 * ks + 8 * hh) * 2;
                o0 = MFMA32(frag_row(STr, PQ, r, kbyte), bq[ks], o0); o1 = MFMA32(frag_row(STr, PQ, 32 + r, kbyte), bq[ks], o1); }
            float ss = 0.f;
#pragma unroll
            for (int reg = 0; reg < 16; ++reg) ss += o0[reg] * o0[reg] + o1[reg] * o1[reg];
            ss += __shfl_xor(ss, 32);
            const float rn = __builtin_amdgcn_rsqf(ss * (1.0f / 64.0f) + HN_EPS);
            const size_t row = rowbase + (size_t)ci * C + 32 * tt + r;
            const bf16_t* grow = z + row * ZW + zg; bf16_t* orow = mixed + row * DM + mcol;
#pragma unroll
            for (int vt = 0; vt < 2; ++vt)
#pragma unroll
                for (int rg = 0; rg < 4; ++rg) { const int v0 = 32 * vt + 8 * rg + 4 * hh; const u32x2 gt2 = *(const u32x2*)(grow + v0);
                    float gv[4] = {bflo(gt2.x), bfhi(gt2.x), bflo(gt2.y), bfhi(gt2.y)}; float res[4];
                    f32x4 gn = {1.f, 1.f, 1.f, 1.f}; if constexpr (GLA) gn = *(const f32x4*)(ngain + v0);
#pragma unroll
                    for (int i = 0; i < 4; ++i) { const float ov = (vt == 0 ? o0[4 * rg + i] : o1[4 * rg + i]) * rn * gn[i]; res[i] = ov * gv[i] * sigmoidf_(gv[i]); }
#if F8_OUT
                    *(unsigned*)((unsigned char*)mixed + row * DM + mcol + v0) = pk4_fp8(res[0], res[1], res[2], res[3]); }
#else
                    u32x2 o; o.x = pk2(res[0], res[1]); o.y = pk2(res[2], res[3]); *(u32x2*)(orow + v0) = o; }
#endif
        } else if (w < NTT + 2 * (DK / 32)) {
            const int kw = w - NTT, vt = kw & 1, ct = kw >> 1;
#pragma unroll
            for (int k2 = 0; k2 < C / 16; ++k2) { const int kb = 16 * k2 + 8 * hh;
                Sacc = MFMA32(frag_tr(Vl, PV, kb, kb + 4, 32 * vt, lane), frag_tr(Kl, PQ, kb, kb + 4, 32 * ct, lane), Sacc); }
            float d; if constexpr (GLA) d = DG[ci * 32 + r]; else d = gC;
#pragma unroll
            for (int reg = 0; reg < 16; ++reg) { Sacc[reg] *= d; *(LAS bf16_t*)(STw + (32 * vt + crow(reg, hh)) * PQ + (32 * ct + r) * 2) = f2bf(Sacc[reg]); }
        }
    }
    __syncthreads();
#undef ISSUE_LOADS
}

DI void gla_stream3(LAS unsigned char* lds, unsigned char* ws_, const float* wg_, const float* bg_, const float* ngain_, int sidx_, int b_, int h_, unsigned long long& tp_t0, unsigned long long& tp_acc) {
    constexpr int C = 64, DK = 32, NC = SEQ / C, PV = 192;
    unsigned char* const ws = uni(ws_); const float* const wgL = uni(wg_); const float* const bgL = uni(bg_); const float* const ngain = uni(ngain_); const int sidx = rfl(sidx_), b = rfl(b_), h = rfl(h_);
    const int tid = opaque_tid(), lane = tid & 63, w = rfl(tid >> 6), r = lane & 31, hh = lane >> 5;
    const size_t rowbase = (size_t)b * SEQ;
    const bf16_t* z = (const bf16_t*)(ws + WS_Z);
    bf16_t* mixed = (bf16_t*)(ws + WS_MIX);
    unsigned char* gs = ws + WS_GS + (size_t)sidx * GS_STRIDE;
    bf16_t* QP = (bf16_t*)gs; bf16_t* KP = (bf16_t*)(gs + 256 * 1024); bf16_t* KPT = (bf16_t*)(gs + 512 * 1024); bf16_t* STs = (bf16_t*)(gs + 768 * 1024);
    float* KVs = (float*)(gs + MiB); float* DG = (float*)(gs + MiB + 512 * 1024);
    const int zq = ZC_GQ + h * 32, zk = ZC_GK + h * 32, zv = ZC_GV + h * 64, zg = ZC_GO + h * 64, mcol = h * 64;
    TP_BEGIN(24);
    {
        const float* wg = wgL + h * 32; const float* bg = bgL + h * 32;
        LAS float* wl = (LAS float*)(lds + 100 * 1024);
        wl[tid] = wg[(tid >> 5) * 128 + (tid & 31)];
        if (tid < 32) wl[512 + tid] = bg[tid];
        __syncthreads();
        for (int chunk = w; chunk < NC; chunk += 8) {
            const size_t trow = (size_t)chunk * C + lane; const bf16_t* zr = z + (rowbase + trow) * ZW;
            const u32x4 g0 = *(const u32x4*)(zr + ZC_LR), g1 = *(const u32x4*)(zr + ZC_LR + 8);
            u32x4 qv[4], kv[4];
#pragma unroll
            for (int j = 0; j < 4; ++j) { qv[j] = *(const u32x4*)(zr + zq + 8 * j); kv[j] = *(const u32x4*)(zr + zk + 8 * j); }
            const float gl[16] = {bflo(g0.x), bfhi(g0.x), bflo(g0.y), bfhi(g0.y), bflo(g0.z), bfhi(g0.z), bflo(g0.w), bfhi(g0.w),
                                  bflo(g1.x), bfhi(g1.x), bflo(g1.y), bfhi(g1.y), bflo(g1.z), bfhi(g1.z), bflo(g1.w), bfhi(g1.w)};
            u32x4 qo[4], ko[4]; float dgv = 0.f;
#pragma unroll
            for (int c4 = 0; c4 < 8; ++c4) {
                f32x4 x = *(const LAS f32x4*)(wl + 512 + 4 * c4);
#pragma unroll
                for (int rr = 0; rr < 16; ++rr) x = x + *(const LAS f32x4*)(wl + rr * 32 + 4 * c4) * gl[rr];
                float qn[4], kn[4];
#pragma unroll
                for (int i = 0; i < 4; ++i) {
                    float v = (fminf(x[i], 0.f) - __logf(1.f + __expf(-fabsf(x[i])))) * (1.0f / 16.0f);
                    v = wave_incl_scan(v);
                    const unsigned qw = qv[c4 >> 1][(c4 & 1) * 2 + (i >> 1)], kw = kv[c4 >> 1][(c4 & 1) * 2 + (i >> 1)];
                    const float qe = (i & 1) ? bfhi(qw) : bflo(qw), ke = (i & 1) ? bfhi(kw) : bflo(kw);
                    const float eq = __expf(v);
                    qn[i] = qe * eq * 0.17677669529663687f; kn[i] = ke * __expf(-v);
                    { const float e63 = __int_as_float(__builtin_amdgcn_readlane(__float_as_int(eq), 63)); dgv = (lane == 4 * c4 + i) ? e63 : dgv; }
                    KPT[((size_t)chunk * 32 + 4 * c4 + i) * 64 + lane] = f2bf(kn[i]);
                }
                qo[c4 >> 1][(c4 & 1) * 2] = pk2(qn[0], qn[1]); qo[c4 >> 1][(c4 & 1) * 2 + 1] = pk2(qn[2], qn[3]);
                ko[c4 >> 1][(c4 & 1) * 2] = pk2(kn[0], kn[1]); ko[c4 >> 1][(c4 & 1) * 2 + 1] = pk2(kn[2], kn[3]);
                __builtin_amdgcn_sched_barrier(0);
            }
#pragma unroll
            for (int j = 0; j < 4; ++j) { *(u32x4*)(QP + trow * DK + 8 * j) = qo[j]; *(u32x4*)(KP + trow * DK + 8 * j) = ko[j]; }
            if (lane < 32) DG[chunk * 32 + lane] = dgv;
        }
    }
    __syncthreads();
    TP_END(24); TP_BEGIN(25);
    LAS unsigned char* Vw = lds + w * (64 * PV);
#define GLA_LOAD_V(chunk_) do { u32x4 vt_[8]; \
        _Pragma("unroll") for (int j = 0; j < 8; ++j) { const int idx = lane + 64 * j; vt_[j] = *(const u32x4*)(z + (rowbase + (size_t)(chunk_) * C + (idx >> 3)) * ZW + zv + (idx & 7) * 8); } \
        _Pragma("unroll") for (int j = 0; j < 8; ++j) { const int idx = lane + 64 * j; *(LAS u32x4*)(Vw + (idx >> 3) * PV + (idx & 7) * 16) = vt_[j]; } } while (0)
    for (int chunk = w; chunk < NC; chunk += 8) {
        GLA_LOAD_V(chunk);
        bf16x8 ka[4];
#pragma unroll
        for (int ks = 0; ks < 4; ++ks) ka[ks] = *(const bf16x8*)(KPT + ((size_t)chunk * 32 + r) * 64 + 16 * ks + 8 * hh);
        f32x16 a0 = zero16(), a1 = zero16();
#pragma unroll
        for (int ks = 0; ks < 4; ++ks) { const int kb = 16 * ks + 8 * hh;
            a0 = MFMA32(ka[ks], frag_tr(Vw, PV, kb, kb + 4, 0, lane), a0); a1 = MFMA32(ka[ks], frag_tr(Vw, PV, kb, kb + 4, 32, lane), a1); }
#pragma unroll
        for (int rg = 0; rg < 4; ++rg) { const int c0 = 8 * rg + 4 * hh;
            *(f32x4*)(KVs + ((size_t)chunk * 64 + r) * 32 + c0) = (f32x4){a0[4 * rg], a0[4 * rg + 1], a0[4 * rg + 2], a0[4 * rg + 3]};
            *(f32x4*)(KVs + ((size_t)chunk * 64 + 32 + r) * 32 + c0) = (f32x4){a1[4 * rg], a1[4 * rg + 1], a1[4 * rg + 2], a1[4 * rg + 3]}; }
    }
    __syncthreads();
    TP_END(25); TP_BEGIN(26);
    { const int v = tid >> 3, c0 = (tid & 7) * 4; f32x4 S = {0.f, 0.f, 0.f, 0.f};
      for (int cb = 0; cb < NC; cb += 8) { f32x4 kvv[8], dd[8];
#pragma unroll
          for (int u = 0; u < 8; ++u) { kvv[u] = *(const f32x4*)(KVs + ((size_t)(cb + u) * 64 + v) * 32 + c0); dd[u] = *(const f32x4*)(DG + (cb + u) * 32 + c0); }
#pragma unroll
          for (int u = 0; u < 8; ++u) { u32x2 o; o.x = pk2(S[0], S[1]); o.y = pk2(S[2], S[3]); *(u32x2*)(STs + ((size_t)(cb + u) * 64 + v) * 32 + c0) = o; S = dd[u] * (S + kvv[u]); } } }
    __syncthreads();
    TP_END(26); TP_BEGIN(27);
    for (int chunk = w; chunk < NC; chunk += 8) {
        GLA_LOAD_V(chunk);
        bf16x8 kf[2][2], sf[2][2], bq[2][2];
#pragma unroll
        for (int a = 0; a < 2; ++a)
#pragma unroll
            for (int ks = 0; ks < 2; ++ks) { const size_t ro = ((size_t)chunk * 64 + 32 * a + r) * 32 + 16 * ks + 8 * hh;
                kf[a][ks] = *(const bf16x8*)(KP + ro); sf[a][ks] = *(const bf16x8*)(STs + ro); bq[a][ks] = *(const bf16x8*)(QP + ro); }
#pragma unroll
        for (int tt = 0; tt < 2; ++tt) {
            f32x16 o0 = zero16(), o1 = zero16();
#pragma unroll
            for (int st = 0; st <= tt; ++st) {
                f32x16 Xs = zero16();
#pragma unroll
                for (int ks = 0; ks < 2; ++ks) Xs = MFMA32(kf[st][ks], bq[tt][ks], Xs);
                if (st == tt) {
#pragma unroll
                    for (int reg = 0; reg < 16; ++reg) if (crow(reg, hh) > r) Xs[reg] = 0.f;
                }
                const bf16x8 x0 = pack8<0>(Xs), x1 = pack8<1>(Xs);
                o0 = MFMA32(frag_tr(Vw, PV, 32 * st + 4 * hh, 32 * st + 8 + 4 * hh, 0, lane), x0, o0);
                o1 = MFMA32(frag_tr(Vw, PV, 32 * st + 4 * hh, 32 * st + 8 + 4 * hh, 32, lane), x0, o1);
                o0 = MFMA32(frag_tr(Vw, PV, 32 * st + 16 + 4 * hh, 32 * st + 24 + 4 * hh, 0, lane), x1, o0);
                o1 = MFMA32(frag_tr(Vw, PV, 32 * st + 16 + 4 * hh, 32 * st + 24 + 4 * hh, 32, lane), x1, o1);
            }
#pragma unroll
            for (int ks = 0; ks < 2; ++ks) { o0 = MFMA32(sf[0][ks], bq[tt][ks], o0); o1 = MFMA32(sf[1][ks], bq[tt][ks], o1); }
            float ss = 0.f;
#pragma unroll
            for (int reg = 0; reg < 16; ++reg) ss += o0[reg] * o0[reg] + o1[reg] * o1[reg];
            ss += __shfl_xor(ss, 32);
            const float rn = __builtin_amdgcn_rsqf(ss * (1.0f / 64.0f) + HN_EPS);
            const size_t row = rowbase + (size_t)chunk * C + 32 * tt + r;
            const bf16_t* grow = z + row * ZW + zg; bf16_t* orow = mixed + row * DM + mcol;
#pragma unroll
            for (int vt = 0; vt < 2; ++vt)
#pragma unroll
                for (int rg = 0; rg < 4; ++rg) { const int v0 = 32 * vt + 8 * rg + 4 * hh; const u32x2 gt2 = *(const u32x2*)(grow + v0);
                    const float gv[4] = {bflo(gt2.x), bfhi(gt2.x), bflo(gt2.y), bfhi(gt2.y)}; float res[4];
                    const f32x4 gn = *(const f32x4*)(ngain + v0);
#pragma unroll
                    for (int i = 0; i < 4; ++i) { const float ov = (vt == 0 ? o0[4 * rg + i] : o1[4 * rg + i]) * rn * gn[i]; res[i] = ov * gv[i] * sigmoidf_(gv[i]); }
#if F8_OUT
                    *(unsigned*)((unsigned char*)mixed + row * DM + mcol + v0) = pk4_fp8(res[0], res[1], res[2], res[3]); }
#else
                    u32x2 o; o.x = pk2(res[0], res[1]); o.y = pk2(res[2], res[3]); *(u32x2*)(orow + v0) = o; }
#endif
        }
    }
#undef GLA_LOAD_V
    __syncthreads();
    TP_END(27);
}

DI float expert_transpose_sum(const float (&pe)[32], int lane) {
    float p16[16], p8[8], p4[4], p2[2];
#pragma unroll
    for (int i = 0; i < 16; ++i) p16[i] = swap32_sum(pe[i], pe[i + 16]);
#pragma unroll
    for (int i = 0; i < 8; ++i) p8[i] = swap16_sum(p16[i], p16[i + 8]);
    { const bool up = (lane & 8) != 0;
#pragma unroll
      for (int i = 0; i < 4; ++i) { const float send = up ? p8[i] : p8[i + 4], keep = up ? p8[i + 4] : p8[i]; p4[i] = keep + dppf<0x128>(send); } }
    { const bool up = (lane & 4) != 0;
#pragma unroll
      for (int i = 0; i < 2; ++i) { const float send = up ? p4[i] : p4[i + 2], keep = up ? p4[i + 2] : p4[i]; p2[i] = keep + dppf<0x1B>(dppf<0x141>(send)); } }
    float p1;
    { const bool up = (lane & 2) != 0; const float send = up ? p2[0] : p2[1], keep = up ? p2[1] : p2[0]; p1 = keep + dppf<0x4E>(send); }
    p1 += dppf<0xB1>(p1);
    return p1;
}
NI void ph_p4(LAS unsigned char* lds_, unsigned char* ws_, const float* wr_, const float* br_, const float* lng_, const float* lnb_, int L_, int G_, int blk_, unsigned long long& tp_t0, unsigned long long& tp_acc) {
    Ctx X = make_ctx(lds_, uni(ws_), rfl(G_), rfl(blk_)); const int L = rfl(L_);
    const float* const wr = uni(wr_); const float* const brp = uni(br_); const float* const lngp = uni(lng_); const float* const lnbp = uni(lnb_);
    unsigned char* ws = X.ws; LAS unsigned char* lds = X.lds;
    LAS float* wrT = (LAS float*)lds;
    LAS int* sel_e = (LAS int*)(lds + 131072 + 1024); LAS float* sel_g = (LAS float*)(lds + 131072 + 1024 + 2048);
    LAS unsigned* hist = (LAS unsigned*)(lds + 131072 + 1024 + 4096); LAS unsigned* base = hist + 32;
    LAS float* wsc = (LAS float*)(lds + 131072 + 6144) + X.wave * 128;
    TP_BEGIN(50);
    { const int e = X.tid & 31, kg = X.tid >> 5;
      for (int m = 0; m < 16; ++m) { const int k0 = kg * 64 + 4 * m; f32x4 w4;
          w4[0] = wr[(k0 + 0) * 32 + e]; w4[1] = wr[(k0 + 1) * 32 + e]; w4[2] = wr[(k0 + 2) * 32 + e]; w4[3] = wr[(k0 + 3) * 32 + e];
          *(LAS f32x4*)(wrT + e * 1024 + k0) = w4; } }
    const float* Y1 = (const float*)(ws + WS_Y1); float* X1 = (float*)(ws + WS_X1); bf16_t* X1B = (bf16_t*)(ws + WS_X1B); unsigned char* X1F8 = ws + WS_X1F8;
    int* list = (int*)(ws + WS_LIST); int* asg = (int*)(ws + WS_ASG); float* gate = (float*)(ws + WS_GATE);
    unsigned* cnt = X.ctl + CW_CNT + L * NEXP;
    const int lane = X.lane;
    __syncthreads();
    TP_END(50);
    for (int grp = X.blk; grp < NTOK / 128; grp += X.G) {
        TP_BEGIN(51);
        if (X.tid < 32) hist[X.tid] = 0u;
        const size_t row0 = (size_t)grp * 128 + X.wave * 16;
        f32x4 nv[2][4];
#pragma unroll
        for (int q = 0; q < 2; ++q)
#pragma unroll
            for (int j = 0; j < 4; ++j) nv[q][j] = *(const f32x4*)(Y1 + (row0 + q) * DM + 4 * lane + 256 * j);
#pragma unroll 1
        for (int it = 0; it < 8; ++it) {
            f32x4 v[2][4];
#pragma unroll
            for (int q = 0; q < 2; ++q)
#pragma unroll
                for (int j = 0; j < 4; ++j) v[q][j] = nv[q][j];
#pragma unroll
            for (int q = 0; q < 2; ++q) { const size_t row = row0 + 2 * it + q;
                float s = 0.f;
#pragma unroll
                for (int j = 0; j < 4; ++j) s += (v[q][j][0] + v[q][j][1]) + (v[q][j][2] + v[q][j][3]);
                const float mean = wave_allsum(s) * (1.f / DM); float s2 = 0.f;
#pragma unroll
                for (int j = 0; j < 4; ++j) { v[q][j] = v[q][j] - mean; s2 += (v[q][j][0] * v[q][j][0] + v[q][j][1] * v[q][j][1]) + (v[q][j][2] * v[q][j][2] + v[q][j][3] * v[q][j][3]); }
                const float rstd = __builtin_amdgcn_rsqf(wave_allsum(s2) * (1.f / DM) + LN_EPS);
                const float* lgq = lngp; const float* lbq = lnbp; asm volatile("" : "+s"(lgq), "+s"(lbq));
#pragma unroll
                for (int j = 0; j < 4; ++j) { const f32x4 lgj = *(const f32x4*)(lgq + 4 * lane + 256 * j), lbj = *(const f32x4*)(lbq + 4 * lane + 256 * j);
                    v[q][j] = v[q][j] * rstd * lgj + lbj; *(f32x4*)(X1 + row * DM + 4 * lane + 256 * j) = v[q][j];
#if !(F8_MOE && F8_PG)
                    { u32x2 o; o.x = pk2(v[q][j][0], v[q][j][1]); o.y = pk2(v[q][j][2], v[q][j][3]); *(u32x2*)(X1B + row * DM + 4 * lane + 256 * j) = o; }
#endif
#if F8_MOE
                    *(unsigned*)(X1F8 + row * DM + 4 * lane + 256 * j) = pk4_fp8(v[q][j][0], v[q][j][1], v[q][j][2], v[q][j][3]);
#endif
                }
            }
            float resA[8], resB[8];
#pragma unroll
            for (int g = 0; g < 8; ++g) { float pa[4], pb[4];
#pragma unroll
                for (int ee = 0; ee < 4; ++ee) { const int e = 4 * g + ee; f32x2 a = {0.f, 0.f}, bsum = {0.f, 0.f};
#pragma unroll
                    for (int j = 0; j < 4; ++j) { const f32x4 wv = *(const LAS f32x4*)(wrT + e * 1024 + 4 * lane + 256 * j); const f32x2 w0 = {wv[0], wv[1]}, w1 = {wv[2], wv[3]};
                        a = a + (f32x2){v[0][j][0], v[0][j][1]} * w0; a = a + (f32x2){v[0][j][2], v[0][j][3]} * w1;
                        bsum = bsum + (f32x2){v[1][j][0], v[1][j][1]} * w0; bsum = bsum + (f32x2){v[1][j][2], v[1][j][3]} * w1; }
                    pa[ee] = a[0] + a[1]; pb[ee] = bsum[0] + bsum[1]; }
                float ta = swap16_sum(swap32_sum(pa[0], pa[2]), swap32_sum(pa[1], pa[3])), tb = swap16_sum(swap32_sum(pb[0], pb[2]), swap32_sum(pb[1], pb[3]));
                ta += dppf<0xB1>(ta); tb += dppf<0xB1>(tb); ta += dppf<0x4E>(ta); tb += dppf<0x4E>(tb); ta += dppf<0x141>(ta); tb += dppf<0x141>(tb); ta += dppf<0x140>(ta); tb += dppf<0x140>(tb);
                resA[g] = ta; resB[g] = tb; }
            if (it + 1 < 8) {
#pragma unroll
                for (int q = 0; q < 2; ++q)
#pragma unroll
                    for (int j = 0; j < 4; ++j) nv[q][j] = *(const f32x4*)(Y1 + (row0 + 2 * (it + 1) + q) * DM + 4 * lane + 256 * j);
            }
            if ((lane & 15) == 0) { const int eo = 2 * (lane >> 5) + ((lane >> 4) & 1);
#pragma unroll
                for (int g = 0; g < 8; ++g) { const float bb = brp[4 * g + eo]; wsc[4 * g + eo] = resA[g] + bb; wsc[32 + 4 * g + eo] = resB[g] + bb; } }
            const int me = lane >> 1, rq = lane & 1;
            const float myv = wsc[rq * 32 + me]; int rank = 0;
#pragma unroll
            for (int e4 = 0; e4 < 8; ++e4) { const f32x4 o = *(const LAS f32x4*)(wsc + rq * 32 + 4 * e4);
#pragma unroll
                for (int i = 0; i < 4; ++i) { const int oe = 4 * e4 + i; rank += ((o[i] > myv) || (o[i] == myv && oe < me)) ? 1 : 0; } }
            if (rank < 4) { ((LAS int*)wsc)[64 + rq * 4 + rank] = me; wsc[72 + rq * 4 + rank] = myv; }
            if (lane < 8) { const int q = lane >> 2, k = lane & 3;
                const f32x4 tv = *(const LAS f32x4*)(wsc + 72 + q * 4); const int mye = ((const LAS int*)wsc)[64 + q * 4 + k];
                const float e0 = 1.0f, e1 = __expf(tv[1] - tv[0]), e2 = __expf(tv[2] - tv[0]), e3 = __expf(tv[3] - tv[0]); const float rs = 1.0f / (e0 + e1 + e2 + e3);
                const float mine = (k == 0 ? e0 : k == 1 ? e1 : k == 2 ? e2 : e3) * rs;
                const int rloc = X.wave * 16 + 2 * it + q; sel_e[rloc * 4 + k] = mye; sel_g[rloc * 4 + k] = mine; }
        }
        __syncthreads();
        TP_END(51); TP_BEGIN(52);
        const int e = sel_e[X.tid]; const float g = sel_g[X.tid];
        const unsigned rank = __hip_atomic_fetch_add(hist + e, 1u, __ATOMIC_RELAXED, __HIP_MEMORY_SCOPE_WORKGROUP);
        __syncthreads();
        if (X.tid < 32) base[X.tid] = __hip_atomic_fetch_add(cnt + X.tid, hist[X.tid], RLX_AGENT);
        __syncthreads();
        const unsigned pos = base[e] + rank; const int tok = grp * 128 + (X.tid >> 2);
        list[(size_t)e * NTOK + pos] = tok; asg[(size_t)tok * 4 + (X.tid & 3)] = (e << 16) | (int)pos; gate[(size_t)tok * 4 + (X.tid & 3)] = g;
        __syncthreads();
        TP_END(52);
    }
}

DI void load_pfx(Ctx& X, int L) {
    __syncthreads();
    if (X.tid == 0) { int acc = 0; const unsigned* cnt = X.ctl + CW_CNT + L * NEXP;
        for (int e = 0; e < NEXP; ++e) { const int c = (int)cnt[e]; X.MISC[MW_PFX + e] = (unsigned)acc; X.MISC[MW_CNT + e] = (unsigned)c; acc += (c + 255) >> 8; }
        X.MISC[MW_PFX + NEXP] = (unsigned)acc; }
    __syncthreads();
}

NI void ph_p7(LAS unsigned char* lds_, unsigned char* ws_, const float* lng_, const float* lnb_, float* xout_, int L_, int G_, int blk_) {
    Ctx X = make_ctx(lds_, uni(ws_), rfl(G_), rfl(blk_)); const int L = rfl(L_);
    const float* const lngp = uni(lng_); const float* const lnbp = uni(lnb_); float* const xout = uni(xout_);
    load_pfx(X, L);
    unsigned char* ws = X.ws;
    const float* X1 = (const float*)(ws + WS_X1); const bf16_t* EP = (const bf16_t*)(ws + WS_EP); const bf16_t* YB = (const bf16_t*)(ws + WS_YB);
    const int* asg = (const int*)(ws + WS_ASG); const float* gate = (const float*)(ws + WS_GATE); bf16_t* XB = (bf16_t*)(ws + WS_XB);
    const int lane = X.lane;
    f32x4 lg[4], lb[4];
#pragma unroll
    for (int j = 0; j < 4; ++j) { lg[j] = *(const f32x4*)(lngp + 4 * lane + 256 * j); lb[j] = *(const f32x4*)(lnbp + 4 * lane + 256 * j); }
    const int shard = (X.blk >> 2) & 63, NSH = X.G >= 256 ? 64 : 1;
    unsigned* const ctr = X.ctl + 32768 + 64 * (64 * L + (NSH == 64 ? shard : 0));
#define P7_GRAB() __builtin_amdgcn_readfirstlane(lane == 0 ? (int)__hip_atomic_fetch_add(ctr, 1u, RLX_AGENT) : 0)
    const int NPAIR = (NTOK / 2) / NSH, pbase = (NSH == 64 ? shard : 0) * NPAIR;
    int pc = P7_GRAB(), pn = P7_GRAB();
    int na[2][4]; f32x4 ng[2];
#pragma unroll
    for (int q = 0; q < 2; ++q) { const int rr = pc < NPAIR ? 2 * (pbase + pc) + q : 0; const u32x4 a4 = *(const u32x4*)(asg + (size_t)rr * 4); na[q][0] = (int)a4.x; na[q][1] = (int)a4.y; na[q][2] = (int)a4.z; na[q][3] = (int)a4.w; ng[q] = *(const f32x4*)(gate + (size_t)rr * 4); }
    while (pc < NPAIR) {
        const int row = 2 * (pbase + pc);
        f32x4 x1v[2][4]; u32x2 epv[2][4], yv[2][4][4]; f32x4 gk[2];
#pragma unroll
        for (int q = 0; q < 2; ++q) { const int rr = row + q; gk[q] = ng[q];
#pragma unroll
            for (int k = 0; k < 4; ++k) { const int a = na[q][k]; const int e = a >> 16, pos = a & 0xffff; const size_t slot = (size_t)X.MISC[MW_PFX + e] * 256 + pos; const bf16_t* yr = YB + slot * DM;
#pragma unroll
                for (int j = 0; j < 4; ++j) yv[q][k][j] = *(const u32x2*)(yr + 4 * lane + 256 * j); }
#pragma unroll
            for (int j = 0; j < 4; ++j) { x1v[q][j] = *(const f32x4*)(X1 + (size_t)rr * DM + 4 * lane + 256 * j); epv[q][j] = *(const u32x2*)(EP + (size_t)rr * DM + 4 * lane + 256 * j); } }
        const int pnn = P7_GRAB();
#pragma unroll
        for (int q = 0; q < 2; ++q) { const int rr = pn < NPAIR ? 2 * (pbase + pn) + q : 0; const u32x4 a4 = *(const u32x4*)(asg + (size_t)rr * 4); na[q][0] = (int)a4.x; na[q][1] = (int)a4.y; na[q][2] = (int)a4.z; na[q][3] = (int)a4.w; ng[q] = *(const f32x4*)(gate + (size_t)rr * 4); }
#pragma unroll
        for (int q = 0; q < 2; ++q) { const int rw = row + q;
            f32x4 v[4];
#pragma unroll
            for (int j = 0; j < 4; ++j) { v[j] = x1v[q][j] * DN_ALPHA + (f32x4){bflo(epv[q][j].x), bfhi(epv[q][j].x), bflo(epv[q][j].y), bfhi(epv[q][j].y)};
#pragma unroll
                for (int k = 0; k < 4; ++k) { const u32x2 y = yv[q][k][j]; v[j] = v[j] + (f32x4){bflo(y.x), bfhi(y.x), bflo(y.y), bfhi(y.y)} * gk[q][k]; } }
            float s_ = 0.f;
#pragma unroll
            for (int j = 0; j < 4; ++j) s_ += (v[j][0] + v[j][1]) + (v[j][2] + v[j][3]);
            const float mean = wave_allsum(s_) * (1.f / DM); float s2 = 0.f;
#pragma unroll
            for (int j = 0; j < 4; ++j) { v[j] = v[j] - mean; s2 += (v[j][0] * v[j][0] + v[j][1] * v[j][1]) + (v[j][2] * v[j][2] + v[j][3] * v[j][3]); }
            const float rstd = __builtin_amdgcn_rsqf(wave_allsum(s2) * (1.f / DM) + LN_EPS);
#pragma unroll
            for (int j = 0; j < 4; ++j) { v[j] = v[j] * rstd * lg[j] + lb[j]; *(f32x4*)(xout + (size_t)rw * DM + 4 * lane + 256 * j) = v[j];
#if F8_IN
                *(unsigned*)((unsigned char*)XB + (size_t)rw * DM + 4 * lane + 256 * j) = pk4_fp8(v[j][0], v[j][1], v[j][2], v[j][3]); } }
#else
                u32x2 o; o.x = pk2(v[j][0], v[j][1]); o.y = pk2(v[j][2], v[j][3]); *(u32x2*)(XB + (size_t)rw * DM + 4 * lane + 256 * j) = o; } }
#endif
        pc = pn; pn = pnn;
    }
#undef P7_GRAB
}

NI void ph_gemm_in(LAS unsigned char* lds, const void* A_, const void* B_, bf16_t* O_, int G_, int blk_) {
    pg8::StaticOrder S; S.init(NTOK, ZW, rfl(G_), rfl(blk_));
    pg8::EpiBf16 E{uni(O_), ZW, nullptr, 0, F8_IN ? 1.0f / 32.0f : 1.0f};
    pg8::gemm_phase<pg8::EpiBf16, pg8::StaticOrder, pg8::NoGather, true, F8_IN != 0>(lds, uni(A_), uni(B_), DM, S, E, pg8::NoGather{});
}
NI void ph_gemm_out(LAS unsigned char* lds, const void* A_, const void* B_, const float* X_, float* Y_, int G_, int blk_) {
    pg8::StaticOrder S; S.init(NTOK, DM, rfl(G_), rfl(blk_));
    pg8::EpiResid E{uni(X_), uni(Y_), DN_ALPHA, F8_OUT ? 1.0f / 32.0f : 1.0f};
    pg8::gemm_phase<pg8::EpiResid, pg8::StaticOrder, pg8::NoGather, true, F8_OUT != 0>(lds, uni(A_), uni(B_), DM, S, E, pg8::NoGather{});
}
NI void ph_gemm_pp(LAS unsigned char* lds, const bf16_t* A_, const bf16_t* B_, bf16_t* O_, int G_, int blk_) {
    pg8::StaticOrder S; S.init(NTOK, DM, rfl(G_), rfl(blk_));
    pg8::EpiBf16 E{uni(O_), DM, nullptr, 0, 1.0f};
    pg8::gemm_phase<pg8::EpiBf16, pg8::StaticOrder, pg8::NoGather, true>(lds, uni(A_), uni(B_), PLE, S, E, pg8::NoGather{});
}
NI void ph_gemm_gu(LAS unsigned char* lds, unsigned char* ws_, const void* A_, const void* B_, void* O_, const float* bias_, const int* list_, int L_, int G_, int blk_) {
    Ctx X = make_ctx(lds, uni(ws_), rfl(G_), rfl(blk_)); load_pfx(X, rfl(L_));
    pg8::MoeOrder S; S.init((const LAS int*)(lds + MISC_OFF) + MW_PFX, (const LAS int*)(lds + MISC_OFF) + MW_CNT, 8, X.G, X.blk, (LAS int*)(lds + MISC_OFF + 30720));
    pg8::MoeGather Gt{uni(list_)};
#if F8_MOE
    pg8::EpiSwiglu<true> E{uni(O_), uni(bias_), 1.0f / 32.0f};
    pg8::gemm_phase<pg8::EpiSwiglu<true>, pg8::MoeOrder, pg8::MoeGather, true, true>(lds, uni(A_), uni(B_), DM, S, E, Gt);
#else
    pg8::EpiSwiglu<false> E{uni(O_), uni(bias_), 1.0f};
    pg8::gemm_phase<pg8::EpiSwiglu<false>, pg8::MoeOrder, pg8::MoeGather, true, false>(lds, uni(A_), uni(B_), DM, S, E, Gt);
#endif
}
NI void ph_gemm_pg(LAS unsigned char* lds, const void* A_, const void* B_, bf16_t* O_, const bf16_t* PP_, const float* bias_, int G_, int blk_) {
    pg8::StaticOrder S; S.init(NTOK, DM, rfl(G_), rfl(blk_));
    pg8::EpiPle E{uni(O_), uni(PP_), uni(bias_), F8_PG ? 1.0f / 32.0f : 1.0f};
    pg8::gemm_phase<pg8::EpiPle, pg8::StaticOrder, pg8::NoGather, true, F8_PG != 0>(lds, uni(A_), uni(B_), DM, S, E, pg8::NoGather{});
}
NI void ph_gemm_dn(LAS unsigned char* lds, unsigned char* ws_, const void* A_, const void* B_, bf16_t* O_, const float* bias_, int L_, int G_, int blk_) {
    Ctx X = make_ctx(lds, uni(ws_), rfl(G_), rfl(blk_)); load_pfx(X, rfl(L_));
    pg8::MoeOrder S; S.init((const LAS int*)(lds + MISC_OFF) + MW_PFX, (const LAS int*)(lds + MISC_OFF) + MW_CNT, 4, X.G, X.blk, (LAS int*)(lds + MISC_OFF + 30720));
#if F8_MOE
    pg8::EpiBf16 E{uni(O_), DM, uni(bias_), DM, 1.0f / 32.0f};
    pg8::gemm_phase<pg8::EpiBf16, pg8::MoeOrder, pg8::NoGather, true, true>(lds, uni(A_), uni(B_), DFF, S, E, pg8::NoGather{});
#else
    pg8::EpiBf16 E{uni(O_), DM, uni(bias_), DM, 1.0f};
    pg8::gemm_phase<pg8::EpiBf16, pg8::MoeOrder, pg8::NoGather, true, false>(lds, uni(A_), uni(B_), DFF, S, E, pg8::NoGather{});
#endif
}
NI void ph_p2(LAS unsigned char* lds, unsigned char* ws_, const float* relb_, const float* dlam_, const float* dnorm_, const float* wg_, const float* bg_, const float* gng_, int L_, int qi_, int G_, int blk_, unsigned long long& tp_t0, unsigned long long& tp_acc) {
    Ctx X = make_ctx(lds, uni(ws_), rfl(G_), rfl(blk_)); const int L = rfl(L_); unsigned char* const ws = X.ws;
    const float* const relb = uni(relb_); const float* const dl = uni(dlam_); const float* const dnorm = uni(dnorm_);
    const float lam_init = L == 0 ? 0.20000000000000007f : L == 1 ? 0.35550906759096934f : L == 2 ? 0.4707130183435842f : 0.5560582041556406f;
    { const int hq = X.tid >> 7, n = X.tid & 127; int bk;
      if (n < 16) bk = n; else { bk = 16 + (int)(__logf((float)n * (1.0f / 16.0f)) / __logf(8.0f) * 16.0f); bk = bk > 31 ? 31 : bk; }
      ((LAS float*)(lds + AT_BIAS_OFF))[hq * 128 + n] = relb[bk * 4 + hq] * LOG2E; }
    if (X.wave == 0) { const float s1 = wave_allsum(dl[X.lane] * dl[64 + X.lane]), s2 = wave_allsum(dl[128 + X.lane] * dl[192 + X.lane]);
        if (X.lane == 0) ((LAS float*)(lds + AT_BIAS_OFF))[512] = __expf(s1) - __expf(s2) + lam_init; }
    __syncthreads();
#ifndef NO_GLA
    TP_BEGIN(22); TP_BEGIN(23); TP_BEGIN(20);
    for (int rep2 = 0; rep2 < ((DUP_MASK >> 8) & 1) + 1; ++rep2)
    for (int s = X.blk; s < 32; s += X.G) gla_stream3(lds, ws, wg_, bg_, gng_, s, s >> 2, s & 3, tp_t0, tp_acc);
    TP_END(20); TP_BEGIN(21);
#endif
#ifndef NO_RET
    for (int rep2 = 0; rep2 < ((DUP_MASK >> 9) & 1) + 1; ++rep2)
    for (int s = (X.blk + X.G - (32 % X.G)) % X.G; s < 32; s += X.G) stream_run<128, 64, false>(lds, ws, wg_, bg_, gng_, 32 + s, s >> 2, s & 3);
#endif
    TP_END(21);
#ifndef NO_ATT
    for (int rep2 = 0; rep2 < ((DUP_MASK >> 10) & 1) + 1; ++rep2) {
    unsigned* qhead = X.ctl + CW_Q + 64 * (rfl(qi_) + 8 * rep2);
    for (;;) {
        if (opaque_tid() == 0) X.MISC[MW_Q] = __hip_atomic_fetch_add(qhead, 1u, RLX_AGENT);
        __syncthreads();
        const int u = rfl((int)X.MISC[MW_Q]);
        __syncthreads();
        if (u >= 1024) break;
        const int qb = 31 - (u >> 5), bh = u & 31;
        const float lam_u = ((const LAS float*)(lds + AT_BIAS_OFF))[512];
        attn_unit(lds, (const bf16_t*)(ws + WS_Z), (bf16_t*)(ws + WS_MIX), bh >> 2, bh & 3, qb, lam_u, 1.0f - lam_init, dnorm, tp_t0, tp_acc);
    }
    }
#endif
    TP_END(22); TP_END(23);
}

constexpr int NPH = 1 + DEPTH * 7;
__global__ void __launch_bounds__(512, 2) fwd_kernel(Args args) {
    extern __shared__ __attribute__((aligned(16))) unsigned char lds_raw[];
    LAS unsigned char* const lds = (LAS unsigned char*)lds_raw;
    volatile LAS unsigned* const MISC = (volatile LAS unsigned*)(lds + MISC_OFF);
    unsigned char* const ws = args.ws; unsigned* const ctl = (unsigned*)(ws + WS_CTL);
    const int G = gridDim.x, blk = blockIdx.x;
    for (int u = threadIdx.x; u < 1024; u += 512) ((LAS unsigned*)(lds + MISC_OFF))[u] = 0u;
    __syncthreads();
#if MK_SPLIT
#define GRID_BAR() do { } while (0)
#else
    XcdBarrier bar = xcd_barrier_post(ctl + CW_BAR, MISC + MW_BAR);
#define GRID_BAR() xcd_barrier(bar)
#endif
    unsigned long long tp_t0 = 0ull, tp_acc = 0ull;
    TP_BEGIN(30);
    const int lo = args.ph_lo, hi = args.ph_hi;
#define IN(k) (lo <= (k) && (k) < hi)
#define SEAM(k) do { if (IN((k) + 1)) GRID_BAR(); } while (0)
#define SPREAD_MARK(ph) do { if (PROBE_ID >= 100 && threadIdx.x == 0) __hip_atomic_store(ctl + 16384 + ((L * 8 + (ph)) << 8) + blockIdx.x, (unsigned)__builtin_amdgcn_s_memrealtime(), RLX_AGENT); } while (0)
#define SPREAD_READ(ph) do { } while (0)
    bf16_t* const XB = (bf16_t*)(ws + WS_XB); bf16_t* const Zb = (bf16_t*)(ws + WS_Z); bf16_t* const MIX = (bf16_t*)(ws + WS_MIX);
    float* const Y1 = (float*)(ws + WS_Y1); bf16_t* const X1B = (bf16_t*)(ws + WS_X1B); bf16_t* const PP = (bf16_t*)(ws + WS_PP); bf16_t* const EP = (bf16_t*)(ws + WS_EP);
    bf16_t* const ACT = (bf16_t*)(ws + WS_ACT); bf16_t* const YB = (bf16_t*)(ws + WS_YB);

#ifndef NO_P0
    if (IN(0)) { TP_BEGIN(0); for (int rep = 0; rep < ((DUP_MASK >> 0) & 1) + 1; ++rep) ph_p0(lds, ws, args.in[0], args.in[1], args.in[2], args.in[8], args.in[14], args.in[16], args.in[18], args.in[20], G, blk); SEAM(0); TP_END(0); }
#endif
    for (int L = 0; L < DEPTH; ++L) {
        const int pb = 1 + L * 7;
#ifndef NO_P1
        if (IN(pb + 0)) { TP_BEGIN(1); for (int rep = 0; rep < ((DUP_MASK >> 1) & 1) + 1; ++rep) ph_gemm_in(lds, XB, ws + WS_WIN + (size_t)L * ZW * DM * (F8_IN ? 1 : 2), Zb, G, blk); SPREAD_MARK(1); SEAM(pb + 0); SPREAD_READ(1); TP_END(1); }
#endif
#ifndef NO_P2
        if (IN(pb + 1)) { TP_BEGIN(2); for (int rep = 0; rep < ((DUP_MASK >> 2) & 1) + 1; ++rep) ph_p2(lds, ws, args.in[9], args.in[6] + (size_t)L * 256, args.in[7] + (size_t)L * 128, args.in[3] + (size_t)L * 16 * 128, args.in[4] + (size_t)L * 128, args.in[5] + (size_t)L * 64, L, L + 4 * rep, G, blk, tp_t0, tp_acc); SPREAD_MARK(2); SEAM(pb + 1); SPREAD_READ(2); TP_END(2); }
#endif
#ifndef NO_P3
        if (IN(pb + 2)) { TP_BEGIN(3); for (int rep = 0; rep < ((DUP_MASK >> 3) & 1) + 1; ++rep) {
            TP_BEGIN(31); ph_gemm_out(lds, MIX, ws + WS_WOUT + (size_t)L * DM * DM * (F8_OUT ? 1 : 2), L == 0 ? args.in[0] : (const float*)args.out, Y1, G, blk); TP_END(31); TP_BEGIN(32);
            ph_gemm_pp(lds, (const bf16_t*)(ws + WS_PB) + (size_t)L * NTOK * PLE, (const bf16_t*)(ws + WS_WPP) + (size_t)L * DM * PLE, PP, G, blk); TP_END(32); }
            SPREAD_MARK(3); SEAM(pb + 2); SPREAD_READ(3); TP_END(3);
        }
#endif
#ifndef NO_P4
        if (IN(pb + 3)) { TP_BEGIN(4); for (int rep = 0; rep < ((DUP_MASK >> 4) & 1) + 1; ++rep) ph_p4(lds, ws, args.in[12] + (size_t)L * DM * NEXP, args.in[13] + (size_t)L * NEXP, args.in[10] + (size_t)L * DM, args.in[11] + (size_t)L * DM, L + 4 * rep, G, blk, tp_t0, tp_acc); SPREAD_MARK(4); SEAM(pb + 3); SPREAD_READ(4); TP_END(4); }
#endif
#ifndef NO_P5
        if (IN(pb + 4)) { TP_BEGIN(5); for (int rep = 0; rep < ((DUP_MASK >> 5) & 1) + 1; ++rep) {
#if F8_MOE
            ph_gemm_gu(lds, ws, ws + WS_X1F8, ws + WS_WGU + (size_t)L * NEXP * 2048 * DM, ACT, args.in[15] + (size_t)L * NEXP * 2048, (const int*)(ws + WS_LIST), L, G, blk);
#else
            ph_gemm_gu(lds, ws, X1B, (const bf16_t*)(ws + WS_WGU) + (size_t)L * NEXP * 2048 * DM, ACT, args.in[15] + (size_t)L * NEXP * 2048, (const int*)(ws + WS_LIST), L, G, blk);
#endif
            ph_gemm_pg(lds, F8_PG ? (const void*)(ws + WS_X1F8) : (const void*)X1B, ws + WS_WPG + (size_t)L * DM * DM * (F8_PG ? 1 : 2), EP, PP, args.in[19] + (size_t)L * DM, G, blk); }
            SPREAD_MARK(5); SEAM(pb + 4); SPREAD_READ(5); TP_END(5);
        }
#endif
#ifndef NO_P6
        if (IN(pb + 5)) { TP_BEGIN(6); for (int rep = 0; rep < ((DUP_MASK >> 6) & 1) + 1; ++rep) ph_gemm_dn(lds, ws, ACT, ws + WS_WDN + (size_t)L * NEXP * DM * DFF * (F8_MOE ? 1 : 2), YB, args.in[17] + (size_t)L * NEXP * DM, L, G, blk); SPREAD_MARK(6); SEAM(pb + 5); SPREAD_READ(6); TP_END(6); }
#endif
#ifndef NO_P7
        if (IN(pb + 6)) { TP_BEGIN(7); for (int rep = 0; rep < ((DUP_MASK >> 7) & 1) + 1; ++rep) ph_p7(lds, ws, args.in[21] + (size_t)L * DM, args.in[22] + (size_t)L * DM, args.out, L, G, blk); SPREAD_MARK(7); if (L + 1 < DEPTH) { SEAM(pb + 6); SPREAD_READ(7); } TP_END(7); }
#endif
    }
#undef IN
#undef SEAM
    TP_END(30);
    if ((PROBE_ID == 40 || PROBE_ID == 41) && blockIdx.x == 0 && threadIdx.x == 0) tp_acc = *(volatile LAS unsigned long long*)(lds + 131072 + 72 * 4);
    if (PROBE_ID >= 100 && blockIdx.x == 0 && threadIdx.x == 0) {
        for (int L = 0; L < 3; ++L) { unsigned mn = 0xffffffffu, mx = 0u;
            for (int q = 0; q < (int)gridDim.x; ++q) { const unsigned v = __hip_atomic_load(ctl + 16384 + ((L * 8 + (PROBE_ID - 100)) << 8) + q, RLX_AGENT); mn = v < mn ? v : mn; mx = v > mx ? v : mx; }
            if (PROBE_ID < 200) tp_acc += (unsigned long long)(mx - mn); } }
    if (PROBE_ID >= 200 && blockIdx.x == 0 && threadIdx.x == 0) {
        for (int L = 0; L < 3; ++L) { unsigned mx = 0u; unsigned long long sm = 0ull; unsigned v0 = __hip_atomic_load(ctl + 16384 + ((L * 8 + (PROBE_ID - 200)) << 8), RLX_AGENT);
            for (int q = 0; q < (int)gridDim.x; ++q) { const unsigned v = __hip_atomic_load(ctl + 16384 + ((L * 8 + (PROBE_ID - 200)) << 8) + q, RLX_AGENT) - v0 + 1000000u; mx = v > mx ? v : mx; sm += v; }
            tp_acc += (unsigned long long)mx - sm / gridDim.x; } }
    if (PROBE_ID >= 0 && blockIdx.x == PROBE_BLK && threadIdx.x == 0) { const unsigned long long tend = __builtin_amdgcn_s_memrealtime() + tp_acc; while (__builtin_amdgcn_s_memrealtime() < tend) __builtin_amdgcn_s_sleep(8); }
}

extern "C" void kernel_launch(void* const* d_in, const int* in_sizes, int n_in, void* d_out, int out_size, void* d_ws, size_t ws_size, hipStream_t stream) {
    static int grid = 0;
    if (grid == 0) {
        if (n_in != 23 || out_size != NTOK * DM || ws_size < WS_END) { fprintf(stderr, "kernel_launch: unexpected shapes (n_in %d, out %d, ws %zu < %zu)\n", n_in, out_size, ws_size, (size_t)WS_END); grid = -1; return; }
        int dev = 0, cus = 0, per_cu = 0;
        if (hipGetDevice(&dev) != hipSuccess || hipDeviceGetAttribute(&cus, hipDeviceAttributeMultiprocessorCount, dev) != hipSuccess) { grid = -1; return; }
        if (hipFuncSetAttribute((const void*)fwd_kernel, hipFuncAttributeMaxDynamicSharedMemorySize, LDS_BYTES) != hipSuccess) { fprintf(stderr, "kernel_launch: hipFuncSetAttribute failed\n"); grid = -1; return; }
        if (hipOccupancyMaxActiveBlocksPerMultiprocessor(&per_cu, (const void*)fwd_kernel, 512, LDS_BYTES) != hipSuccess || per_cu < 1) { fprintf(stderr, "kernel_launch: occupancy query says %d\n", per_cu); }
        (void)hipGetLastError();
        grid = cus;
    }
    if (grid < 0) return;
    (void)hipMemsetAsync((char*)d_ws + WS_CTL, 0, CTL_ZERO_BYTES, stream);
    Args a{};
    for (int i = 0; i < 23; ++i) a.in[i] = (const float*)d_in[i];
    a.out = (float*)d_out; a.ws = (unsigned char*)d_ws;
#if MK_SPLIT
    for (int p = 0; p < NPH; ++p) { a.ph_lo = p; a.ph_hi = p + 1; hipLaunchKernelGGL(fwd_kernel, dim3(grid), dim3(512), LDS_BYTES, stream, a); }
#else
    a.ph_lo = 0; a.ph_hi = NPH;
    hipLaunchKernelGGL(fwd_kernel, dim3(grid), dim3(512), LDS_BYTES, stream, a);
#endif
}
```

```cpp
#include <hip/hip_runtime.h>
#include <cstdio>
#include <cstdint>

#ifndef DUP_MASK
#define DUP_MASK 0
#endif
#ifndef PROBE_ID
#define PROBE_ID -1
#endif
#define PROBE_BLK (PROBE_ID == 21 ? 32 : (PROBE_ID == 22 || PROBE_ID == 28) ? 64 : 0)
#define TP_BEGIN(id) do { if (PROBE_ID == (id) && blockIdx.x == PROBE_BLK) { tp_t0 = __builtin_amdgcn_s_memrealtime(); } } while (0)
#define TP_END(id) do { if (PROBE_ID == (id) && blockIdx.x == PROBE_BLK) { tp_acc += __builtin_amdgcn_s_memrealtime() - tp_t0; } } while (0)
#ifndef F8_MOE
#define F8_MOE 1
#endif
#ifndef F8_OUT
#define F8_OUT 1
#endif
#ifndef F8_IN
#define F8_IN 0
#endif
#ifndef F8_PG
#define F8_PG 1
#endif
#ifndef BF16_RESID
#define BF16_RESID 1
#endif
#ifndef Y1_F32
#define Y1_F32 0
#endif
#ifndef YB_F8
#define YB_F8 1
#endif
#ifndef MOE_CVT_P2
#define MOE_CVT_P2 1
#endif
#ifndef EP_F8
#define EP_F8 1
#endif
#ifndef PP_F8
#define PP_F8 1
#endif
#ifndef MK_SPLIT
#define MK_SPLIT 0
#endif

#define GAS __attribute__((address_space(1)))
#define LAS __attribute__((address_space(3)))
#define DI __device__ __forceinline__
typedef unsigned short bf16_t;
typedef short bf16x8 __attribute__((ext_vector_type(8)));
typedef short s16x4 __attribute__((ext_vector_type(4)));
typedef short v4i16_t __attribute__((ext_vector_type(4)));
typedef float f32x2 __attribute__((ext_vector_type(2)));
typedef float f32x4 __attribute__((ext_vector_type(4)));
typedef float f32x16 __attribute__((ext_vector_type(16)));
typedef unsigned u32x2 __attribute__((ext_vector_type(2)));
typedef unsigned u32x4 __attribute__((ext_vector_type(4)));
typedef __bf16 bf16x2_t __attribute__((ext_vector_type(2)));
typedef int v4i_t __attribute__((ext_vector_type(4)));
typedef int v8i_t __attribute__((ext_vector_type(8)));

constexpr int NB = 8, SEQ = 4096, DM = 1024, DEPTH = 4, NTOK = NB * SEQ;
constexpr int INW = 3344;
constexpr int ZW = 3584;
constexpr int ZC_GQ = 0, ZC_GK = 128, ZC_GV = 256, ZC_GO = 512, ZC_DQ = 768, ZC_DK = 1280, ZC_DV = 1792,
              ZC_RQ = 2304, ZC_RK = 2560, ZC_RV = 2816, ZC_RG = 3072, ZC_LR = 3328;
constexpr int NEXP = 32, TOPK = 4, DFF = 1024, PLE = 256;
constexpr int MAXSLOT = NTOK * TOPK + NEXP * 256;
constexpr float LN_EPS = 1e-5f, HN_EPS = 1e-5f;
constexpr float DN_ALPHA = 1.681792830507429f;
constexpr float LOG2E = 1.4426950408889634f;

__device__ const double kThetaRev[32] = {0.15915494309189535, 0.11824638530245714, 0.08785280158734302, 0.06527146455262238, 0.04849434517587465, 0.036029550281362475, 0.02676865702112893, 0.01988814717694384,
    0.01477617639986849, 0.010978166395165499, 0.008156381877047283, 0.0060598977032741905, 0.004502285538822983, 0.0033450358513712635, 0.0024852410515669447, 0.0018464445102618582,
    0.0013718417082023314, 0.0010192289353426582, 0.0007572503565305745, 0.0005626097166019918, 0.00041799873778229564, 0.0003105579936352166, 0.00023073339389116236, 0.00017142659389752471,
    0.00012736377946734852, 9.462669677672228e-05, 7.03042244845543e-05, 5.2233504378126876e-05, 3.8807610774786524e-05, 2.8832655820772147e-05, 2.14216238794896e-05, 1.5915494309189534e-05};

constexpr size_t MiB = 1u << 20;
constexpr size_t WS_CTL = 0, CTL_ZERO_BYTES = 1 * MiB;
constexpr size_t WS_SINCOS = 1 * MiB;
constexpr size_t WS_LIST = 2 * MiB;
constexpr size_t WS_ASG = 6 * MiB;
constexpr size_t WS_GATE = 7 * MiB;
constexpr size_t WS_WIN = 8 * MiB;
constexpr size_t WS_WOUT = 36 * MiB;
constexpr size_t WS_WPG = 44 * MiB;
constexpr size_t WS_WPP = 52 * MiB;
constexpr size_t WS_WGU = 64 * MiB;
constexpr size_t WS_WDN = 576 * MiB;
constexpr size_t WS_XB = 832 * MiB;
constexpr size_t WS_X1 = 896 * MiB;
constexpr size_t WS_X1B = 1024 * MiB;
constexpr size_t WS_Y1 = 1088 * MiB;
constexpr size_t WS_Z = 1216 * MiB;
constexpr size_t WS_MIX = 1440 * MiB;
constexpr size_t WS_PB = 1504 * MiB;
constexpr size_t WS_PP = 1568 * MiB;
constexpr size_t WS_EP = 1632 * MiB;
constexpr size_t WS_ACT = 1696 * MiB;
constexpr size_t WS_YB = 1968 * MiB;
constexpr size_t WS_GS = 2240 * MiB;
constexpr size_t WS_X1F8 = 2240 * MiB + 64 * 2 * MiB;
constexpr size_t GS_STRIDE = 2 * MiB;
constexpr size_t WS_END = WS_X1F8 + 32 * MiB;
static_assert(WS_ACT + (size_t)MAXSLOT * 1024 * 2 <= WS_YB && WS_YB + (size_t)MAXSLOT * 1024 * 2 <= WS_GS, "ws map");
constexpr int CW_BAR = 4096;
constexpr int CW_CNT = 8192;
constexpr int CW_Q = 8704;

constexpr int RING_BYTES = 131072;
constexpr int MISC_OFF = RING_BYTES;
constexpr int LDS_BYTES = 163840;
constexpr int MW_BAR = 8, MW_Q = 16, MW_PFX = 32, MW_CNT = 96;

DI unsigned pk2(float lo, float hi) { f32x2 v = {lo, hi}; bf16x2_t b = __builtin_convertvector(v, bf16x2_t); return __builtin_bit_cast(unsigned, b); }
DI float bflo(unsigned w) { return __uint_as_float(w << 16); }
DI float bfhi(unsigned w) { return __uint_as_float(w & 0xffff0000u); }
DI float bf2f(bf16_t h) { return __uint_as_float((unsigned)h << 16); }
DI bf16_t f2bf(float f) { return (bf16_t)(pk2(f, 0.f) & 0xffffu); }
DI unsigned pk4_fp8(float a, float b, float c, float d) { int w = __builtin_amdgcn_cvt_pk_fp8_f32(a, b, 0, false); w = __builtin_amdgcn_cvt_pk_fp8_f32(c, d, w, true); return (unsigned)w; }
DI int rfl(int v) { return __builtin_amdgcn_readfirstlane(v); }
template <class T> DI T* uni(T* p) { const unsigned long long v = (unsigned long long)p; const unsigned lo = (unsigned)__builtin_amdgcn_readfirstlane((int)(unsigned)v), hi = (unsigned)__builtin_amdgcn_readfirstlane((int)(unsigned)(v >> 32));
    return (T*)(GAS T*)(((unsigned long long)hi << 32) | lo); }
DI float unif(float v) { return __uint_as_float((unsigned)__builtin_amdgcn_readfirstlane((int)__float_as_uint(v))); }
#define NI __device__ __forceinline__
DI int opaque_tid() { int t = (int)threadIdx.x; asm volatile("" : "+v"(t)); return t; }
DI float wave_sum(float v) {
#pragma unroll
    for (int o = 1; o < 64; o <<= 1) v += __shfl_xor(v, o);
    return v;
}
DI float sigmoidf_(float x) { return __builtin_amdgcn_rcpf(1.f + __builtin_amdgcn_exp2f(-x * LOG2E)); }

#ifndef EPI_NT
#define EPI_NT 0
#endif
#if EPI_NT
#define EPI_ST(p, v) __builtin_nontemporal_store((v), (p))
#else
#define EPI_ST(p, v) (*(p) = (v))
#endif
namespace pg8 {
constexpr int BM = 256, BK = 64, HALF = 128, HTB = HALF * BK * 2, STAGE_BYTES = 8 * HTB, NXCD = 8, WGM = 4;
__host__ __device__ __forceinline__ int lds_byte(int r, int c) { const int st = (r >> 4) * 2 + (c >> 5), rr = r & 15, cc = c & 31, ob = rr * 64 + cc * 2; return st * 1024 + (ob ^ (((ob >> 9) & 1) << 5)); }
__host__ __device__ __forceinline__ void stage_rc(int b, int& R, int& C) { const int st = b / 1024, sb = b % 1024, swz = sb ^ (((sb >> 9) & 1) << 5); R = (st >> 1) * 16 + swz / 64; C = (st & 1) * 32 + (swz % 64) / 2; }
__host__ __device__ __forceinline__ int perm32(int rho) { const int n = rho >> 4, i = rho & 15; return 8 * (i >> 2) + 4 * n + (i & 3); }

struct Unit { int pm, pn, pb, e, r0, cnt; };

DI void order_map(int L, int nM, int nN, int nwg, int& pm, int& pn) {
    int wgid = L; { const int q = nwg / NXCD, r = nwg % NXCD, xcd = wgid % NXCD, off = wgid / NXCD; wgid = (xcd < r ? xcd * (q + 1) : r * (q + 1) + (xcd - r) * q) + off; }
    const int nig = WGM * nN, gid = wgid / nig, fm = gid * WGM, gsz = (nM - fm) < WGM ? (nM - fm) : WGM;
    pm = fm + ((wgid % nig) % gsz); pn = (wgid % nig) / gsz;
}
struct StaticOrder {
    static constexpr bool IS_MOE = false;
    int nM, nN, nwg, G, c;
    DI void init(int M, int N, int G_, int c_) { nM = M / BM; nN = N / BM; nwg = nM * nN; G = G_; c = c_; }
    DI bool next(int i, Unit& u) const {
        const long L = (long)i * G + c; if (L >= nwg) return false;
        order_map((int)L, nM, nN, nwg, u.pm, u.pn); u.pb = u.pn; u.e = 0; u.r0 = 0; u.cnt = 0; return true;
    }
};
struct MoeOrder {
    static constexpr bool IS_MOE = true;
    const LAS int* tab;
    DI void init(const LAS int* pfx, const LAS int* cnts, int nN, int G, int c, LAS int* tab_) {
        tab = tab_; const int t = threadIdx.x;
        if (t < 20) { const int nM = pfx[NEXP], nwg = nM * nN; const long L = (long)t * G + c; int pm = -1, pn = 0, e = 0;
            if (L < nwg) { order_map((int)L, nM, nN, nwg, pm, pn);
                for (int j = 1; j < NEXP; ++j) { if (pfx[j] <= pm) e = j; } }
            tab_[t * 8 + 0] = pm; tab_[t * 8 + 1] = pn; tab_[t * 8 + 2] = e * nN + pn; tab_[t * 8 + 3] = e; tab_[t * 8 + 4] = pm < 0 ? 0 : (pm - pfx[e]) * BM; tab_[t * 8 + 5] = cnts[e]; }
        __syncthreads();
    }
    DI bool next(int i, Unit& u) const {
        if (i >= 20) return false;
        const int pm = rfl(tab[i * 8 + 0]); if (pm < 0) return false;
        u.pm = pm; u.pn = rfl(tab[i * 8 + 1]); u.pb = rfl(tab[i * 8 + 2]); u.e = rfl(tab[i * 8 + 3]); u.r0 = rfl(tab[i * 8 + 4]); u.cnt = rfl(tab[i * 8 + 5]); return true;
    }
};
struct NoGather { static constexpr bool ON = false; DI unsigned tok(const Unit&, int) const { return 0u; } };
struct MoeGather { static constexpr bool ON = true; const int* list;
    DI unsigned tok(const Unit& u, int row) const { const int p = u.r0 + row; return (unsigned)list[(size_t)u.e * NTOK + (p < u.cnt ? p : u.cnt - 1)]; } };

template <bool OUT8 = false> struct EpiBf16T {
    static constexpr bool PERM = true;
    bf16_t* O; int ldc; const float* bias; int bias_estride; float ascale;
    DI const float* bias_ptr(const Unit& u) const { return bias ? bias + (size_t)u.e * bias_estride + u.pn * BM : nullptr; }
    DI void operator()(const f32x4 (&acc)[2][2][4][2], const Unit& u, int wr, int wc, int fr, int fq, const LAS float* biasL) const {
        const int row0 = u.pm * BM + wr * 64 + fr; const int cl = wc * 32 + 8 * fq; const int col0 = u.pn * BM + cl;
        f32x4 bv[2][2];
#pragma unroll
        for (int bj = 0; bj < 2; ++bj)
#pragma unroll
            for (int n = 0; n < 2; ++n) bv[bj][n] = bias ? *(const LAS f32x4*)(biasL + cl + bj * HALF + 4 * n) : (f32x4){0.f, 0.f, 0.f, 0.f};
#pragma unroll
        for (int ai = 0; ai < 2; ++ai)
#pragma unroll
            for (int m = 0; m < 4; ++m) { const size_t eoff = (size_t)(row0 + ai * HALF + m * 16) * ldc + col0;
#pragma unroll
                for (int bj = 0; bj < 2; ++bj) { const f32x4 v0 = acc[ai][bj][m][0] * ascale + bv[bj][0], v1 = acc[ai][bj][m][1] * ascale + bv[bj][1];
                    if constexpr (OUT8) { u32x2 w8; w8.x = pk4_fp8(v0[0], v0[1], v0[2], v0[3]); w8.y = pk4_fp8(v1[0], v1[1], v1[2], v1[3]); EPI_ST((u32x2*)((unsigned char*)O + eoff + bj * HALF), w8); }
                    else { u32x4 w; w.x = pk2(v0[0], v0[1]); w.y = pk2(v0[2], v0[3]); w.z = pk2(v1[0], v1[1]); w.w = pk2(v1[2], v1[3]); EPI_ST((u32x4*)(O + eoff + bj * HALF), w); } } }
    }
};
typedef EpiBf16T<false> EpiBf16;
struct EpiResid {
    static constexpr bool PERM = false;
    const float* X; float* Y; float alpha; float ascale;
    DI const float* bias_ptr(const Unit&) const { return nullptr; }
    DI void operator()(const f32x4 (&acc)[2][2][4][2], const Unit& u, int wr, int wc, int fr, int fq, const LAS float*) const {
        const int col0 = u.pn * BM + wc * 32 + 4 * fq;
        const size_t rbase = (size_t)(u.pm * BM + wr * 64 + fr) * DM + col0;
        f32x4 xs[2][2][2][2];
#define RES_LOAD(b_) do { _Pragma("unroll") for (int mm = 0; mm < 2; ++mm) _Pragma("unroll") for (int bj = 0; bj < 2; ++bj) _Pragma("unroll") for (int n = 0; n < 2; ++n) \
            xs[(b_) & 1][mm][bj][n] = *(const f32x4*)(X + rbase + (size_t)(((b_) >> 1) * HALF + (2 * ((b_) & 1) + mm) * 16) * DM + bj * HALF + n * 16); } while (0)
        RES_LOAD(0);
#pragma unroll
        for (int b = 0; b < 4; ++b) {
            if (b < 3) RES_LOAD(b + 1);
            __builtin_amdgcn_sched_barrier(0);
#pragma unroll
            for (int mm = 0; mm < 2; ++mm)
#pragma unroll
                for (int bj = 0; bj < 2; ++bj)
#pragma unroll
                    for (int n = 0; n < 2; ++n) EPI_ST((f32x4*)(Y + rbase + (size_t)((b >> 1) * HALF + (2 * (b & 1) + mm) * 16) * DM + bj * HALF + n * 16), xs[b & 1][mm][bj][n] * alpha + acc[b >> 1][bj][2 * (b & 1) + mm][n] * ascale);
            __builtin_amdgcn_sched_barrier(0);
        }
#undef RES_LOAD
    }
};
struct EpiResidXB {
    static constexpr bool PERM = false;
    const bf16_t* X; float* Y; float alpha; float ascale;
    DI const float* bias_ptr(const Unit&) const { return nullptr; }
    DI void operator()(const f32x4 (&acc)[2][2][4][2], const Unit& u, int wr, int wc, int fr, int fq, const LAS float*) const {
        const int col0 = u.pn * BM + wc * 32 + 4 * fq;
        const size_t rbase = (size_t)(u.pm * BM + wr * 64 + fr) * DM + col0;
        u32x2 xs[2][2][2][2];
#define RESX_LOAD(b_) do { _Pragma("unroll") for (int mm = 0; mm < 2; ++mm) _Pragma("unroll") for (int bj = 0; bj < 2; ++bj) _Pragma("unroll") for (int n = 0; n < 2; ++n) \
            xs[(b_) & 1][mm][bj][n] = *(const u32x2*)(X + rbase + (size_t)(((b_) >> 1) * HALF + (2 * ((b_) & 1) + mm) * 16) * DM + bj * HALF + n * 16); } while (0)
        RESX_LOAD(0);
#pragma unroll
        for (int b = 0; b < 4; ++b) {
            if (b < 3) RESX_LOAD(b + 1);
            __builtin_amdgcn_sched_barrier(0);
#pragma unroll
            for (int mm = 0; mm < 2; ++mm)
#pragma unroll
                for (int bj = 0; bj < 2; ++bj)
#pragma unroll
                    for (int n = 0; n < 2; ++n) { const u32x2 x = xs[b & 1][mm][bj][n]; const f32x4 xf = {bflo(x.x), bfhi(x.x), bflo(x.y), bfhi(x.y)};
                        EPI_ST((f32x4*)(Y + rbase + (size_t)((b >> 1) * HALF + (2 * (b & 1) + mm) * 16) * DM + bj * HALF + n * 16), xf * alpha + acc[b >> 1][bj][2 * (b & 1) + mm][n] * ascale); }
            __builtin_amdgcn_sched_barrier(0);
        }
#undef RESX_LOAD
    }
};
struct EpiResidB {
    static constexpr bool PERM = true;
    const bf16_t* X; bf16_t* Y; float alpha; float ascale;
    DI const float* bias_ptr(const Unit&) const { return nullptr; }
    DI void operator()(const f32x4 (&acc)[2][2][4][2], const Unit& u, int wr, int wc, int fr, int fq, const LAS float*) const {
        const int col0 = u.pn * BM + wc * 32 + 8 * fq;
        const size_t rbase = (size_t)(u.pm * BM + wr * 64 + fr) * DM + col0;
        u32x4 xs[2][2][2];
#define RESB_LOAD(b_) do { _Pragma("unroll") for (int mm = 0; mm < 2; ++mm) _Pragma("unroll") for (int bj = 0; bj < 2; ++bj) \
            xs[(b_) & 1][mm][bj] = *(const u32x4*)(X + rbase + (size_t)(((b_) >> 1) * HALF + (2 * ((b_) & 1) + mm) * 16) * DM + bj * HALF); } while (0)
        RESB_LOAD(0);
#pragma unroll
        for (int b = 0; b < 4; ++b) {
            if (b < 3) RESB_LOAD(b + 1);
            __builtin_amdgcn_sched_barrier(0);
#pragma unroll
            for (int mm = 0; mm < 2; ++mm)
#pragma unroll
                for (int bj = 0; bj < 2; ++bj) { const int ai = b >> 1, m = 2 * (b & 1) + mm; const u32x4 x = xs[b & 1][mm][bj];
                    const f32x4 v0 = acc[ai][bj][m][0] * ascale, v1 = acc[ai][bj][m][1] * ascale;
                    u32x4 w; w.x = pk2(bflo(x.x) * alpha + v0[0], bfhi(x.x) * alpha + v0[1]); w.y = pk2(bflo(x.y) * alpha + v0[2], bfhi(x.y) * alpha + v0[3]);
                    w.z = pk2(bflo(x.z) * alpha + v1[0], bfhi(x.z) * alpha + v1[1]); w.w = pk2(bflo(x.w) * alpha + v1[2], bfhi(x.w) * alpha + v1[3]);
                    EPI_ST((u32x4*)(Y + rbase + (size_t)(ai * HALF + m * 16) * DM + bj * HALF), w); }
            __builtin_amdgcn_sched_barrier(0);
        }
#undef RESB_LOAD
    }
};
template <bool OUT8> struct EpiSwiglu {
    static constexpr bool PERM = true;
    void* O; const float* bias; float ascale;
    DI const float* bias_ptr(const Unit& u) const { return bias + (size_t)u.e * 2048 + u.pn * BM; }
    DI void operator()(const f32x4 (&acc)[2][2][4][2], const Unit& u, int wr, int wc, int fr, int fq, const LAS float* biasL) const {
        const int row0 = u.pm * BM + wr * 64 + fr; const int cl = wc * 32 + 8 * fq; const int col0 = u.pn * BM + cl;
        f32x4 bv[2][2];
#pragma unroll
        for (int bj = 0; bj < 2; ++bj)
#pragma unroll
            for (int n = 0; n < 2; ++n) bv[bj][n] = *(const LAS f32x4*)(biasL + cl + bj * HALF + 4 * n);
#pragma unroll
        for (int ai = 0; ai < 2; ++ai)
#pragma unroll
            for (int m = 0; m < 4; ++m) { const size_t eoff = (size_t)(row0 + ai * HALF + m * 16) * DFF + (col0 >> 1);
#pragma unroll
                for (int bj = 0; bj < 2; ++bj) { const f32x4 v0 = acc[ai][bj][m][0] * ascale + bv[bj][0], v1 = acc[ai][bj][m][1] * ascale + bv[bj][1];
                    float a[4];
#pragma unroll
                    for (int k = 0; k < 4; ++k) { const float g = fminf(k < 2 ? v0[2 * k] : v1[2 * k - 4], 7.0f); const float uu = fminf(fmaxf(k < 2 ? v0[2 * k + 1] : v1[2 * k - 3], -7.0f), 7.0f);
                        a[k] = (uu + 1.0f) * (g * sigmoidf_(g * 1.702f)); }
                    if constexpr (OUT8) { EPI_ST((unsigned*)((unsigned char*)O + eoff + bj * (HALF / 2)), pk4_fp8(a[0], a[1], a[2], a[3])); }
                    else { u32x2 w; w.x = pk2(a[0], a[1]); w.y = pk2(a[2], a[3]); EPI_ST((u32x2*)((bf16_t*)O + eoff + bj * (HALF / 2)), w); } } }
    }
};
struct EpiPle {
    static constexpr bool PERM = true;
    bf16_t* O; const bf16_t* PP; const float* bias; float ascale;
    DI const float* bias_ptr(const Unit& u) const { return bias + u.pn * BM; }
    DI void operator()(const f32x4 (&acc)[2][2][4][2], const Unit& u, int wr, int wc, int fr, int fq, const LAS float* biasL) const {
        const int row0 = u.pm * BM + wr * 64 + fr; const int cl = wc * 32 + 8 * fq; const int col0 = u.pn * BM + cl;
        f32x4 bv[2][2];
#pragma unroll
        for (int bj = 0; bj < 2; ++bj)
#pragma unroll
            for (int n = 0; n < 2; ++n) bv[bj][n] = *(const LAS f32x4*)(biasL + cl + bj * HALF + 4 * n);
#if PP_F8 && EP_F8
        u32x2 ppv[2][2][2];
#define PLE_LOAD(b_) do { _Pragma("unroll") for (int mm = 0; mm < 2; ++mm) _Pragma("unroll") for (int bj = 0; bj < 2; ++bj) \
            ppv[(b_) & 1][mm][bj] = *(const u32x2*)((const unsigned char*)PP + (size_t)(row0 + ((b_) >> 1) * HALF + (2 * ((b_) & 1) + mm) * 16) * DM + col0 + bj * HALF); } while (0)
#else
        u32x4 ppv[2][2][2];
#define PLE_LOAD(b_) do { _Pragma("unroll") for (int mm = 0; mm < 2; ++mm) _Pragma("unroll") for (int bj = 0; bj < 2; ++bj) \
            ppv[(b_) & 1][mm][bj] = *(const u32x4*)(PP + (size_t)(row0 + ((b_) >> 1) * HALF + (2 * ((b_) & 1) + mm) * 16) * DM + col0 + bj * HALF); } while (0)
#endif
        PLE_LOAD(0);
#pragma unroll
        for (int b = 0; b < 4; ++b) {
            if (b < 3) PLE_LOAD(b + 1);
            __builtin_amdgcn_sched_barrier(0);
#pragma unroll
            for (int mm = 0; mm < 2; ++mm) { const int ai = b >> 1, m = 2 * (b & 1) + mm; const size_t off = (size_t)(row0 + ai * HALF + m * 16) * DM + col0;
#pragma unroll
                for (int bj = 0; bj < 2; ++bj) { const f32x4 v0 = acc[ai][bj][m][0] * ascale + bv[bj][0], v1 = acc[ai][bj][m][1] * ascale + bv[bj][1];
#if PP_F8 && EP_F8
                    { const u32x2 p8 = ppv[b & 1][mm][bj];
                      const f32x2 p01 = __builtin_amdgcn_cvt_pk_f32_fp8((int)p8.x, false), p23 = __builtin_amdgcn_cvt_pk_f32_fp8((int)p8.x, true), p45 = __builtin_amdgcn_cvt_pk_f32_fp8((int)p8.y, false), p67 = __builtin_amdgcn_cvt_pk_f32_fp8((int)p8.y, true);
                      u32x2 w8; w8.x = pk4_fp8(sigmoidf_(v0[0]) * p01[0], sigmoidf_(v0[1]) * p01[1], sigmoidf_(v0[2]) * p23[0], sigmoidf_(v0[3]) * p23[1]);
                      w8.y = pk4_fp8(sigmoidf_(v1[0]) * p45[0], sigmoidf_(v1[1]) * p45[1], sigmoidf_(v1[2]) * p67[0], sigmoidf_(v1[3]) * p67[1]);
                      EPI_ST((u32x2*)((unsigned char*)O + off + bj * HALF), w8); }
#else
                    const u32x4 pp = ppv[b & 1][mm][bj];
                    u32x4 w; w.x = pk2(sigmoidf_(v0[0]) * bflo(pp.x), sigmoidf_(v0[1]) * bfhi(pp.x)); w.y = pk2(sigmoidf_(v0[2]) * bflo(pp.y), sigmoidf_(v0[3]) * bfhi(pp.y));
                    w.z = pk2(sigmoidf_(v1[0]) * bflo(pp.z), sigmoidf_(v1[1]) * bfhi(pp.z)); w.w = pk2(sigmoidf_(v1[2]) * bflo(pp.w), sigmoidf_(v1[3]) * bfhi(pp.w));
#if EP_F8
                    { u32x2 w8; w8.x = pk4_fp8(16.f * sigmoidf_(v0[0]) * bflo(pp.x), 16.f * sigmoidf_(v0[1]) * bfhi(pp.x), 16.f * sigmoidf_(v0[2]) * bflo(pp.y), 16.f * sigmoidf_(v0[3]) * bfhi(pp.y));
                      w8.y = pk4_fp8(16.f * sigmoidf_(v1[0]) * bflo(pp.z), 16.f * sigmoidf_(v1[1]) * bfhi(pp.z), 16.f * sigmoidf_(v1[2]) * bflo(pp.w), 16.f * sigmoidf_(v1[3]) * bfhi(pp.w));
                      EPI_ST((u32x2*)((unsigned char*)O + off + bj * HALF), w8); }
#else
                    EPI_ST((u32x4*)(O + off + bj * HALF), w);
#endif
#endif
                } }
            __builtin_amdgcn_sched_barrier(0);
        }
#undef PLE_LOAD
    }
};

template <class Epi, class Sched, class Gath, bool ALIGN_EPI, bool F8 = false>
DI void gemm_phase(LAS unsigned char* lds, const void* Abase, const void* Bbase, const int K, const Sched& S, const Epi& E, const Gath& G) {
    const int tid = opaque_tid(), wid = rfl(tid >> 6), lane = tid & 63, wr = wid >> 2, wc = wid & 3, fr = lane & 15, fq = lane >> 4;
    const int PB = F8 ? K : 2 * K;
    const int nt = PB / 128;
    unsigned voffA[2], voffB[2];
#pragma unroll
    for (int i = 0; i < 2; ++i) { int R, C; stage_rc(tid * 16 + i * 8192, R, C); const int Rb = Epi::PERM ? ((R & ~31) + perm32(R & 31)) : R;
        voffA[i] = (unsigned)(R * PB + C * 2); voffB[i] = (unsigned)(Rb * PB + C * 2); }
    const size_t kstep = (size_t)(BK * 2);
    const size_t hstep = (size_t)HALF * PB;
    const size_t tstep = 2 * hstep;
    const unsigned ldsw = (unsigned)wid * 1024u;
    const int aoff = lds_byte(wr * 64 + fr, fq * 8), boff = lds_byte(wc * 32 + fr, fq * 8);
#define PG8_SA(b, h) (((b) * 2 + (h)) * HTB)
#define PG8_SB(b, h) ((4 + (b) * 2 + (h)) * HTB)
#define PG8_STAGE(bufoff, gbase, voff) do { _Pragma("unroll") for (int _i = 0; _i < 2; ++_i) \
        __builtin_amdgcn_global_load_lds((const unsigned*)((const char*)(gbase) + (voff)[_i]), (LAS unsigned*)(lds + (bufoff) + ldsw + _i * 8192), 16, 0, 0); } while (0)
#define PG8_STA(bufoff, kptr, h, VG) do { if constexpr (Gath::ON) { PG8_STAGE(bufoff, kptr, VG[h]); } else { PG8_STAGE(bufoff, (kptr) + (h) * hstep, voffA); } } while (0)
#define PG8_LDA(dst, b, h) do { _Pragma("unroll") for (int m = 0; m < 4; ++m) { \
        if constexpr (F8) { dst##8[m] = PG8_CAT8(*(const LAS v4i_t*)(lds + PG8_SA(b, h) + aoff + m * 2048), *(const LAS v4i_t*)(lds + PG8_SA(b, h) + aoff + m * 2048 + 1024)); } \
        else { _Pragma("unroll") for (int k = 0; k < 2; ++k) dst[m][k] = *(const LAS bf16x8*)(lds + PG8_SA(b, h) + aoff + m * 2048 + k * 1024); } } } while (0)
#define PG8_LDB(dst, b, h) do { _Pragma("unroll") for (int n = 0; n < 2; ++n) { \
        if constexpr (F8) { dst##8[n] = PG8_CAT8(*(const LAS v4i_t*)(lds + PG8_SB(b, h) + boff + n * 2048), *(const LAS v4i_t*)(lds + PG8_SB(b, h) + boff + n * 2048 + 1024)); } \
        else { _Pragma("unroll") for (int k = 0; k < 2; ++k) dst[n][k] = *(const LAS bf16x8*)(lds + PG8_SB(b, h) + boff + n * 2048 + k * 1024); } } } while (0)
#define PG8_CAT8(x0, x1) __builtin_shufflevector((x0), (x1), 0, 1, 2, 3, 4, 5, 6, 7)
#define PG8_MMA(ai, bj, At, Bt) do { __builtin_amdgcn_s_setprio(1); _Pragma("unroll") for (int m = 0; m < 4; ++m) _Pragma("unroll") for (int n = 0; n < 2; ++n) { \
        if constexpr (F8) { asm volatile("v_mfma_scale_f32_16x16x128_f8f6f4 %0, %1, %2, %0, %3, %3 op_sel_hi:[0,0,0]" : "+v"(acc[ai][bj][m][n]) : "v"(Bt##8[n]), "v"(At##8[m]), "v"(sc127)); } \
        else { _Pragma("unroll") for (int k = 0; k < 2; ++k) acc[ai][bj][m][n] = __builtin_amdgcn_mfma_f32_16x16x32_bf16(Bt[n][k], At[m][k], acc[ai][bj][m][n], 0, 0, 0); } } __builtin_amdgcn_s_setprio(0); } while (0)
#define PG8_WAIT_V(n) asm volatile("s_waitcnt vmcnt(" #n ")" ::: "memory")
#define PG8_WAIT_L(n) asm volatile("s_waitcnt lgkmcnt(" #n ")" ::: "memory")
#define PG8_BAR __builtin_amdgcn_s_barrier()
#define PG8_SCHED __builtin_amdgcn_sched_barrier(0)
    Unit cur, nxt; int ui = 0; unsigned long long pg_t0 = 0ull, pg_acc = 0ull;
    if (!S.next(0, cur)) return;
    f32x4 acc[2][2][4][2];
#pragma unroll
    for (int a = 0; a < 2; ++a)
#pragma unroll
        for (int b = 0; b < 2; ++b)
#pragma unroll
            for (int m = 0; m < 4; ++m)
#pragma unroll
                for (int n = 0; n < 2; ++n) { acc[a][b][m][n] = (f32x4){0.f, 0.f, 0.f, 0.f}; }
    bf16x8 At[4][2], B0[2][2], B1[2][2]; v8i_t At8[4], B08[2], B18[2]; const int sc127 = 127;
    unsigned vgC[2][2], vgN[2][2];
    LAS unsigned* const gtab = (LAS unsigned*)(lds + 131072 + 10240);
    if constexpr (Gath::ON) {
        unsigned gt[20];
#pragma unroll
        for (int i = 0; i < 20; ++i) { Unit uu; gt[i] = 0u; if (S.next(i, uu) && tid < 256) gt[i] = G.tok(uu, tid) * (unsigned)PB; }
#pragma unroll
        for (int i = 0; i < 20; ++i) if (tid < 256) gtab[i * 256 + tid] = gt[i];
        __syncthreads();
    }
#define PG8_GOFF(dst, unit_) do { _Pragma("unroll") for (int h = 0; h < 2; ++h) _Pragma("unroll") for (int i = 0; i < 2; ++i) { int R_, C_; stage_rc(opaque_tid() * 16 + i * 8192, R_, C_); \
        dst[h][i] = gtab[(unit_) * 256 + h * HALF + R_] + (unsigned)C_ * 2u; } } while (0)
#pragma unroll
    for (int h = 0; h < 2; ++h)
#pragma unroll
        for (int i = 0; i < 2; ++i) { vgC[h][i] = 0u; vgN[h][i] = 0u; }
    if constexpr (Gath::ON) { PG8_GOFF(vgC, 0); }
    const char* cA = Gath::ON ? (const char*)Abase : (const char*)Abase + (size_t)cur.pm * tstep; const char* cB = (const char*)Bbase + (size_t)cur.pb * tstep;
    LAS float* const biasL0 = (LAS float*)(lds + 131072 + 8192);
#define PG8_BIAS_DMA(unit_, slot_) do { const float* bp_ = E.bias_ptr(unit_); if (bp_ != nullptr && wid == 0) \
        __builtin_amdgcn_global_load_lds((const unsigned*)(bp_ + 4 * lane), (LAS unsigned*)(biasL0 + 256 * (slot_)), 16, 0, 0); } while (0)
    PG8_BIAS_DMA(cur, 0);
    PG8_STAGE(PG8_SB(0, 0), cB, voffB); PG8_STAGE(PG8_SB(0, 1), cB + hstep, voffB); PG8_STA(PG8_SA(0, 0), cA, 0, vgC); PG8_STA(PG8_SA(0, 1), cA, 1, vgC);
    if (wr == 1) PG8_BAR;
    PG8_WAIT_V(2); PG8_BAR;
    PG8_STAGE(PG8_SB(1, 0), cB + kstep, voffB); PG8_STA(PG8_SA(1, 0), cA + kstep, 0, vgC); PG8_STAGE(PG8_SB(1, 1), cB + hstep + kstep, voffB);
    PG8_WAIT_V(6); PG8_BAR;
    for (;;) {
        const bool has_next = S.next(ui + 1, nxt);
        const char* nA = has_next ? (Gath::ON ? (const char*)Abase : (const char*)Abase + (size_t)nxt.pm * tstep) : cA; const char* nB = has_next ? (const char*)Bbase + (size_t)nxt.pb * tstep : cB;
        if constexpr (F8 && !Gath::ON && Sched::IS_MOE) { if (PROBE_ID == 40 && blockIdx.x == 0) pg_t0 = __builtin_amdgcn_s_memrealtime(); }
#pragma unroll 1
        for (int t = 0; t < nt; t += 2) {
            const bool last = (t == nt - 2);
            const char* a1 = cA + (size_t)(t + 1) * kstep;
            const char* a2 = last ? nA : cA + (size_t)(t + 2) * kstep; const char* b2 = last ? nB : cB + (size_t)(t + 2) * kstep;
            const char* a3 = a2 + kstep; const char* b3 = b2 + kstep;
            unsigned vs[2][2];
#pragma unroll
            for (int h = 0; h < 2; ++h)
#pragma unroll
                for (int i = 0; i < 2; ++i) vs[h][i] = vgC[h][i];
            if constexpr (Gath::ON) { if (last && has_next) { PG8_GOFF(vs, ui + 1); } }
            PG8_LDB(B0, 0, 0); PG8_LDB(B1, 0, 1); PG8_SCHED; PG8_LDA(At, 0, 0); PG8_STA(PG8_SA(1, 1), a1, 1, vgC);
            PG8_WAIT_V(8); PG8_WAIT_L(0); PG8_BAR; PG8_MMA(0, 0, At, B0); PG8_MMA(0, 1, At, B1); PG8_BAR; PG8_SCHED;
            PG8_LDA(At, 0, 1); PG8_STAGE(PG8_SB(0, 0), b2, voffB); PG8_STAGE(PG8_SB(0, 1), b2 + hstep, voffB); PG8_STA(PG8_SA(0, 0), a2, 0, vs);
            PG8_WAIT_V(8); PG8_WAIT_L(0); PG8_BAR; PG8_MMA(1, 0, At, B0); PG8_MMA(1, 1, At, B1); PG8_BAR; PG8_SCHED;
            PG8_LDB(B0, 1, 0); PG8_LDB(B1, 1, 1); PG8_SCHED; PG8_LDA(At, 1, 0); PG8_STA(PG8_SA(0, 1), a2, 1, vs);
            PG8_WAIT_V(8); PG8_WAIT_L(0); PG8_BAR; PG8_MMA(0, 0, At, B0); PG8_MMA(0, 1, At, B1); PG8_BAR; PG8_SCHED;
            PG8_LDA(At, 1, 1); PG8_STAGE(PG8_SB(1, 0), b3, voffB); PG8_STAGE(PG8_SB(1, 1), b3 + hstep, voffB); PG8_STA(PG8_SA(1, 0), a3, 0, vs);
            PG8_WAIT_V(8); PG8_WAIT_L(0); PG8_BAR; PG8_MMA(1, 0, At, B0); PG8_MMA(1, 1, At, B1); PG8_BAR; PG8_SCHED;
        }
        if constexpr (F8 && !Gath::ON && Sched::IS_MOE) { if (PROBE_ID == 40 && blockIdx.x == 0) pg_acc += __builtin_amdgcn_s_memrealtime() - pg_t0; if (PROBE_ID == 41 && blockIdx.x == 0) pg_t0 = __builtin_amdgcn_s_memrealtime(); }
        if constexpr (ALIGN_EPI) { if (wr == 0) PG8_BAR; }
        if constexpr (F8) { asm volatile("s_nop 15\n\ts_nop 15" ::: "memory"); }
        E(acc, cur, wr, wc, fr, fq, biasL0 + 256 * (ui & 1));
        if constexpr (F8 && !Gath::ON && Sched::IS_MOE) { if (PROBE_ID == 41 && blockIdx.x == 0) { asm volatile("s_waitcnt vmcnt(0)" ::: "memory"); pg_acc += __builtin_amdgcn_s_memrealtime() - pg_t0; } }
        if (!has_next) break;
#pragma unroll
        for (int a = 0; a < 2; ++a)
#pragma unroll
            for (int b = 0; b < 2; ++b)
#pragma unroll
                for (int m = 0; m < 4; ++m)
#pragma unroll
                    for (int n = 0; n < 2; ++n) { acc[a][b][m][n] = (f32x4){0.f, 0.f, 0.f, 0.f}; }
        cur = nxt; cA = nA; cB = nB; ++ui;
        PG8_BIAS_DMA(cur, ui & 1);
        if constexpr (Gath::ON) { PG8_GOFF(vgC, ui); }
        if constexpr (ALIGN_EPI) { if (wr == 1) PG8_BAR; }
    }
    PG8_WAIT_V(0);
    if constexpr (!ALIGN_EPI) { if (wr == 0) PG8_BAR; }
    PG8_BAR;
    if constexpr (F8 && !Gath::ON && Sched::IS_MOE) { if ((PROBE_ID == 40 || PROBE_ID == 41) && blockIdx.x == 0 && tid == 0) { volatile LAS unsigned long long* pa = (volatile LAS unsigned long long*)(lds + 131072 + 72 * 4); *pa = *pa + pg_acc; } }
#undef PG8_SA
#undef PG8_SB
#undef PG8_STAGE
#undef PG8_STA
#undef PG8_LDA
#undef PG8_LDB
#undef PG8_MMA
#undef PG8_BIAS_DMA
#undef PG8_GOFF
#undef PG8_CAT8
#undef PG8_WAIT_V
#undef PG8_WAIT_L
#undef PG8_BAR
#undef PG8_SCHED
}
}

typedef GAS unsigned gu32;
#define RLX_AGENT __ATOMIC_RELAXED, __HIP_MEMORY_SCOPE_AGENT
#define XB_TMO      128
#define XB_XCNT(j)  (256  + 64 * (j))
#define XB_XSUB(j)  (1280 + 64 * (j))
#define XB_XGEN(j)  (2304 + 64 * (j))
#define XB_TOP      3328
#define XB_TOPGEN   3392
#define XCD_BAR_WORDS 3456
#define XB_SPIN_CAP (1u << 18)
DI unsigned xb_ld(unsigned* p)              { return __hip_atomic_load(p, __ATOMIC_RELAXED, __HIP_MEMORY_SCOPE_AGENT); }
DI unsigned xb_add(unsigned* p, unsigned v) { return __hip_atomic_fetch_add(p, v, __ATOMIC_RELAXED, __HIP_MEMORY_SCOPE_AGENT); }
DI unsigned xb_xcc_id() { return (unsigned)__builtin_amdgcn_s_getreg((3 << 11) | 20) & 0xFu; }
#define XB_SPIN(cond, bar) do { unsigned _sp = 0; while (cond) { __builtin_amdgcn_s_sleep(1); \
    if ((++_sp & 255u) == 0u) { if (xb_ld(&(bar)[XB_TMO])) break; if (_sp > XB_SPIN_CAP) { atomicAdd(&(bar)[XB_TMO], 1u); break; } } } } while (0)
struct XcdBarrier { unsigned* bar; unsigned x; volatile LAS unsigned* st; };
DI XcdBarrier xcd_barrier_post(unsigned* bar, volatile LAS unsigned* st) {
    XcdBarrier b; b.bar = bar; b.x = xb_xcc_id(); b.st = st;
    if (threadIdx.x == 0) (void)xb_add(&bar[XB_XCNT(b.x)], 1u);
    return b;
}
DI void xcd_barrier_complete(unsigned* bar, unsigned x, unsigned& nloc, unsigned& nx) {
    const unsigned G = gridDim.x * gridDim.y * gridDim.z;
    unsigned sum, cnt, mine, sp = 0u;
    for (;;) {
        sum = 0u; cnt = 0u; mine = 0u;
#pragma unroll
        for (unsigned j = 0; j < 16; ++j) { const unsigned c = xb_ld(&bar[XB_XCNT(j)]); sum += c; cnt += (c > 0u) ? 1u : 0u; mine = (j == x) ? c : mine; }
        if (sum == G) break;
        __builtin_amdgcn_s_sleep(1);
        if ((++sp & 255u) == 0u) { if (xb_ld(&bar[XB_TMO])) break; if (sp > XB_SPIN_CAP) { atomicAdd(&bar[XB_TMO], 1u); break; } }
    }
    nloc = mine > 0u ? mine : 1u; nx = cnt > 0u ? cnt : 1u;
}
DI void xcd_barrier(const XcdBarrier& b) {
    asm volatile("s_waitcnt vmcnt(0)" ::: "memory");
    __syncthreads();
    if (threadIdx.x == 0) {
        unsigned* bar = b.bar;
        __builtin_amdgcn_s_waitcnt(0);
        unsigned nloc = b.st[0], nx = b.st[1];
        if (nloc == 0u) { xcd_barrier_complete(bar, b.x, nloc, nx); b.st[0] = nloc; b.st[1] = nx; }
        const unsigned old = xb_add(&bar[XB_XSUB(b.x)], 1u);
        const unsigned gen = old / nloc;
        if (old + 1u == (gen + 1u) * nloc) {
            __builtin_amdgcn_fence(__ATOMIC_RELEASE, "agent");
            asm volatile("s_waitcnt vmcnt(0)" ::: "memory");
            const unsigned og = xb_add(&bar[XB_TOP], 1u);
            const unsigned tg = og / nx;
            if (og + 1u == (tg + 1u) * nx) xb_add(&bar[XB_TOPGEN], 1u);
            else XB_SPIN(xb_ld(&bar[XB_TOPGEN]) == tg, bar);
            __builtin_amdgcn_fence(__ATOMIC_ACQUIRE, "agent");
            xb_add(&bar[XB_XGEN(b.x)], 1u);
            asm volatile("s_waitcnt vmcnt(0)" ::: "memory");
        } else {
            XB_SPIN(xb_ld(&bar[XB_XGEN(b.x)]) == gen, bar);
            __builtin_amdgcn_fence(__ATOMIC_ACQUIRE, "agent");
            asm volatile("s_waitcnt vmcnt(0)" ::: "memory");
        }
    }
    __syncthreads();
}

struct Args {
    const float* in[23]; float* out; unsigned char* ws; int ph_lo, ph_hi;
};
struct Ctx {
    LAS unsigned char* lds; volatile LAS unsigned* MISC; unsigned* ctl; unsigned char* ws;
    int tid, lane, wave, G, blk;
};
DI Ctx make_ctx(LAS unsigned char* lds, unsigned char* ws, int G, int blk) {
    Ctx X; X.lds = lds; X.MISC = (volatile LAS unsigned*)(lds + 131072); X.ws = ws; X.ctl = (unsigned*)ws;
    X.tid = opaque_tid(); X.lane = X.tid & 63; X.wave = __builtin_amdgcn_readfirstlane(X.tid >> 6); X.G = G; X.blk = blk; return X;
}

#define MFMA32(a, b, c) __builtin_amdgcn_mfma_f32_32x32x16_bf16((a), (b), (c), 0, 0, 0)
DI int crow(int reg, int h) { return (reg & 3) + 8 * (reg >> 2) + 4 * h; }
DI s16x4 tr16(const LAS unsigned char* p) { return __builtin_bit_cast(s16x4, __builtin_amdgcn_ds_read_tr16_b64_v4i16((LAS v4i16_t*)p)); }
DI bf16x8 frag_tr(const LAS unsigned char* img, int pitch, int k_lo, int k_hi, int m0, int lane) {
    const int i16 = lane & 15, q = i16 >> 2, p = i16 & 3, blk = (lane >> 4) & 1;
    const LAS unsigned char* a = img + (m0 + 16 * blk + 4 * p) * 2;
    const s16x4 lo = tr16(a + (k_lo + q) * pitch), hi = tr16(a + (k_hi + q) * pitch);
    return __builtin_shufflevector(lo, hi, 0, 1, 2, 3, 4, 5, 6, 7);
}
DI bf16x8 frag_row(const LAS unsigned char* img, int pitch, int row, int kbyte) { return *(const LAS bf16x8*)(img + row * pitch + kbyte); }
template <int s> DI bf16x8 pack8(const f32x16& x) {
    u32x4 p; p.x = pk2(x[8 * s], x[8 * s + 1]); p.y = pk2(x[8 * s + 2], x[8 * s + 3]); p.z = pk2(x[8 * s + 4], x[8 * s + 5]); p.w = pk2(x[8 * s + 6], x[8 * s + 7]);
    return __builtin_bit_cast(bf16x8, p);
}
DI f32x16 zero16() { f32x16 z;
#pragma unroll
    for (int i = 0; i < 16; ++i) z[i] = 0.f;
    return z; }
DI f32x16 splat16(float v) { f32x16 z;
#pragma unroll
    for (int i = 0; i < 16; ++i) z[i] = v;
    return z; }

template <int CTRL> DI float dppf(float v) { return __int_as_float(__builtin_amdgcn_update_dpp(0, __float_as_int(v), CTRL, 0xf, 0xf, false)); }
DI float swap16_sum(float a, float b) { const auto rr = __builtin_amdgcn_permlane16_swap(__float_as_uint(a), __float_as_uint(b), false, false); return __uint_as_float(rr[0]) + __uint_as_float(rr[1]); }
DI float swap32_sum(float a, float b) { const auto rr = __builtin_amdgcn_permlane32_swap(__float_as_uint(a), __float_as_uint(b), false, false); return __uint_as_float(rr[0]) + __uint_as_float(rr[1]); }
DI float wave_allsum(float v) {
    v += dppf<0xB1>(v); v += dppf<0x4E>(v); v += dppf<0x141>(v); v += dppf<0x140>(v);
    v = swap16_sum(v, v); v = swap32_sum(v, v); return v;
}
template <int CTRL, int RM> DI float dppz(float v) { return __int_as_float(__builtin_amdgcn_update_dpp(0, __float_as_int(v), CTRL, RM, 0xf, false)); }
DI float wave_incl_scan(float v) {
    v += dppz<0x111, 0xf>(v); v += dppz<0x112, 0xf>(v); v += dppz<0x114, 0xf>(v); v += dppz<0x118, 0xf>(v);
    v += dppz<0x142, 0xa>(v); v += dppz<0x143, 0xc>(v); return v;
}
DI void transpose_item(const float* W, int K, int srcN, bf16_t* WT, int k0, int n0dst, int scol, int nvalid, LAS float* scr, int lane) {
    const int cl = lane & 31; const bool ok = cl < nvalid;
    float tv[32];
    const float* src = W + (size_t)(k0 + (lane >> 5)) * srcN + scol + cl;
#pragma unroll
    for (int i = 0; i < 32; ++i) tv[i] = ok ? __builtin_nontemporal_load(src + (size_t)(2 * i) * srcN) : 0.f;
#pragma unroll
    for (int i = 0; i < 32; ++i) scr[(2 * i + (lane >> 5)) * 33 + cl] = tv[i];
    asm volatile("s_waitcnt lgkmcnt(0)" ::: "memory");
    const int c = lane & 7;
#pragma unroll
    for (int j = 0; j < 4; ++j) { const int n = (lane >> 3) + 8 * j; const LAS float* s = scr + (8 * c) * 33 + n;
        u32x4 o; o.x = pk2(s[0 * 33], s[1 * 33]); o.y = pk2(s[2 * 33], s[3 * 33]); o.z = pk2(s[4 * 33], s[5 * 33]); o.w = pk2(s[6 * 33], s[7 * 33]);
        *(u32x4*)(WT + (size_t)(n0dst + n) * K + k0 + 8 * c) = o; }
    asm volatile("s_waitcnt lgkmcnt(0)" ::: "memory");
}
DI void transpose_item_f8(const float* W, int K, int srcN, unsigned char* WT, int k0, int n0dst, int scol, int nvalid, float wscale, LAS float* scr, int lane) {
    const int cl = lane & 31; const bool ok = cl < nvalid;
    float tv[32];
    const float* src = W + (size_t)(k0 + (lane >> 5)) * srcN + scol + cl;
#pragma unroll
    for (int i = 0; i < 32; ++i) tv[i] = ok ? __builtin_nontemporal_load(src + (size_t)(2 * i) * srcN) : 0.f;
#pragma unroll
    for (int i = 0; i < 32; ++i) scr[(2 * i + (lane >> 5)) * 33 + cl] = tv[i] * wscale;
    asm volatile("s_waitcnt lgkmcnt(0)" ::: "memory");
    const int c = lane & 7;
#pragma unroll
    for (int j = 0; j < 4; ++j) { const int n = (lane >> 3) + 8 * j; const LAS float* sp = scr + (8 * c) * 33 + n;
        u32x2 o; o.x = pk4_fp8(sp[0 * 33], sp[1 * 33], sp[2 * 33], sp[3 * 33]); o.y = pk4_fp8(sp[4 * 33], sp[5 * 33], sp[6 * 33], sp[7 * 33]);
        *(u32x2*)(WT + (size_t)(n0dst + n) * K + k0 + 8 * c) = o; }
    asm volatile("s_waitcnt lgkmcnt(0)" ::: "memory");
}
DI void transpose_batch(Ctx& X, const float* W, bf16_t* WT, int nmat, int K, int N, int gw, int NGW, LAS float* scr) {
    const int nb = N / 32, per = (K / 64) * nb; const long total = (long)nmat * per;
    for (long it = gw; it < total; it += NGW) { const int mat = (int)(it / per), r = (int)(it % per), kb = r / nb, nbk = r % nb;
        transpose_item(W + (size_t)mat * K * N, K, N, WT + (size_t)mat * K * N, 64 * kb, 32 * nbk, 32 * nbk, 32, scr, X.lane); }
}
DI void transpose_batch_f8(Ctx& X, const float* W, unsigned char* WT, int nmat, int K, int N, float wscale, int gw, int NGW, LAS float* scr) {
    const int nb = N / 32, per = (K / 64) * nb; const long total = (long)nmat * per;
    const int lane = X.lane, cl = lane & 31, c = lane & 7;
    float tv[32];
#define TB8_LOAD(it_) do { const int mat_ = (int)((it_) / per), r_ = (int)((it_) % per), kb_ = r_ / nb, nbk_ = r_ % nb; \
        const float* src_ = W + (size_t)mat_ * K * N + (size_t)(64 * kb_ + (lane >> 5)) * N + 32 * nbk_ + cl; \
        _Pragma("unroll") for (int i = 0; i < 32; ++i) tv[i] = __builtin_nontemporal_load(src_ + (size_t)(2 * i) * N); } while (0)
    long it = gw;
    if (it < total) TB8_LOAD(it);
    for (; it < total; it += NGW) {
        const int mat = (int)(it / per), r = (int)(it % per), kb = r / nb, nbk = r % nb;
#pragma unroll
        for (int i = 0; i < 32; ++i) scr[(2 * i + (lane >> 5)) * 33 + cl] = tv[i] * wscale;
        if (it + NGW < total) TB8_LOAD(it + NGW);
        asm volatile("s_waitcnt lgkmcnt(0)" ::: "memory");
        unsigned char* WTm = WT + (size_t)mat * K * N;
#pragma unroll
        for (int j = 0; j < 4; ++j) { const int n = (lane >> 3) + 8 * j; const LAS float* sp = scr + (8 * c) * 33 + n;
            u32x2 o; o.x = pk4_fp8(sp[0 * 33], sp[1 * 33], sp[2 * 33], sp[3 * 33]); o.y = pk4_fp8(sp[4 * 33], sp[5 * 33], sp[6 * 33], sp[7 * 33]);
            *(u32x2*)(WTm + (size_t)(32 * nbk + n) * K + 64 * kb + 8 * c) = o; }
        asm volatile("s_waitcnt lgkmcnt(0)" ::: "memory");
    }
#undef TB8_LOAD
}
NI void ph_p0(LAS unsigned char* lds_, unsigned char* ws_, const float* x_, const float* p_, const float* w_in_, const float* w_out_, const float* w_gu_, const float* w_dn_, const float* w_pg_, const float* w_pp_, int G_, int blk_) {
    Ctx X = make_ctx(lds_, uni(ws_), rfl(G_), rfl(blk_));
    const float* const in0 = uni(x_); const float* const in1 = uni(p_); const float* const in2 = uni(w_in_); const float* const in8 = uni(w_out_);
    const float* const in14 = uni(w_gu_); const float* const in16 = uni(w_dn_); const float* const in18 = uni(w_pg_); const float* const in20 = uni(w_pp_);
    LAS float* scr = (LAS float*)(X.lds + X.wave * 16384);
    const int gw = X.blk * 8 + X.wave, NGW = X.G * 8;
    unsigned char* ws = X.ws;
    { const int nb = ZW / 32, per = 16 * nb; const long total = (long)DEPTH * per;
      for (long it = gw; it < total; it += NGW) { const int mat = (int)(it / per), r = (int)(it % per), kb = r / nb, nbk = r % nb, n0 = 32 * nbk;
          int scol, nv; if (n0 < 512) { scol = n0; nv = 32; } else if (n0 < 3328) { scol = n0 + 16; nv = 32; } else if (n0 == 3328) { scol = 512; nv = 16; } else { scol = 0; nv = 0; }
#if F8_IN
          transpose_item_f8(in2 + (size_t)mat * DM * INW, DM, INW, ws + WS_WIN + (size_t)mat * ZW * DM, 64 * kb, n0, scol, nv, 32.0f, scr, X.lane); } }
#else
          transpose_item(in2 + (size_t)mat * DM * INW, DM, INW, (bf16_t*)(ws + WS_WIN) + (size_t)mat * ZW * DM, 64 * kb, n0, scol, nv, scr, X.lane); } }
#endif
#if F8_OUT
    transpose_batch_f8(X, in8, ws + WS_WOUT, DEPTH, DM, DM, 32.0f, gw, NGW, scr);
#else
    transpose_batch(X, in8, (bf16_t*)(ws + WS_WOUT), DEPTH, DM, DM, gw, NGW, scr);
#endif
#if F8_PG
    transpose_batch_f8(X, in18, ws + WS_WPG, DEPTH, DM, DM, 32.0f, gw, NGW, scr);
#else
    transpose_batch(X, in18, (bf16_t*)(ws + WS_WPG), DEPTH, DM, DM, gw, NGW, scr);
#endif
    transpose_batch(X, in20, (bf16_t*)(ws + WS_WPP), DEPTH, PLE, DM, gw, NGW, scr);
#if F8_MOE && MOE_CVT_P2
    (void)in14; (void)in16;
#elif F8_MOE
    transpose_batch_f8(X, in14, ws + WS_WGU, DEPTH * NEXP, DM, 2 * DFF, 32.0f, gw, NGW, scr);
    transpose_batch_f8(X, in16, ws + WS_WDN, DEPTH * NEXP, DFF, DM, 32.0f, gw, NGW, scr);
#else
    transpose_batch(X, in14, (bf16_t*)(ws + WS_WGU), DEPTH * NEXP, DM, 2 * DFF, gw, NGW, scr);
    transpose_batch(X, in16, (bf16_t*)(ws + WS_WDN), DEPTH * NEXP, DFF, DM, gw, NGW, scr);
#endif
    const long gt = (long)X.blk * 512 + X.tid, NGT = (long)X.G * 512;
#define CVT_STREAM(SRC, DST, N8) do { const f32x4* src = (const f32x4*)(SRC); u32x4* dst = (u32x4*)(DST); const long n8 = (N8); \
      for (long i = gt; i < n8; i += 4 * NGT) { f32x4 a[4], b[4]; \
          _Pragma("unroll") for (int u = 0; u < 4; ++u) { const long ii = i + u * NGT; if (ii < n8) { a[u] = __builtin_nontemporal_load(src + 2 * ii); b[u] = __builtin_nontemporal_load(src + 2 * ii + 1); } } \
          _Pragma("unroll") for (int u = 0; u < 4; ++u) { const long ii = i + u * NGT; if (ii < n8) { u32x4 o; o.x = pk2(a[u][0], a[u][1]); o.y = pk2(a[u][2], a[u][3]); o.z = pk2(b[u][0], b[u][1]); o.w = pk2(b[u][2], b[u][3]); dst[ii] = o; } } } } while (0)
#if F8_IN
    { const f32x4* src = (const f32x4*)in0; u32x2* dst = (u32x2*)(ws + WS_XB); const long n8 = (long)NTOK * DM / 8;
      for (long i = gt; i < n8; i += NGT) { const f32x4 a = __builtin_nontemporal_load(src + 2 * i), b = __builtin_nontemporal_load(src + 2 * i + 1); u32x2 o; o.x = pk4_fp8(a[0], a[1], a[2], a[3]); o.y = pk4_fp8(b[0], b[1], b[2], b[3]); dst[i] = o; } }
#else
    CVT_STREAM(in0, ws + WS_XB, (long)NTOK * DM / 8);
#endif
    CVT_STREAM(in1, ws + WS_PB, (long)DEPTH * NTOK * PLE / 8);
#undef CVT_STREAM
    { f32x2* sc = (f32x2*)(ws + WS_SINCOS);
      for (long i = gt; i < (long)SEQ * 32; i += NGT) { const int t = (int)(i >> 5), j = (int)(i & 31); const double rev = (double)t * kThetaRev[j]; const float fr = (float)(rev - __builtin_floor(rev));
          sc[i] = (f32x2){__builtin_amdgcn_sinf(fr), __builtin_amdgcn_cosf(fr)}; } }
}

constexpr int AT_KP = 272, AT_VP = 320, AT_KB = 64 * AT_KP, AT_VB = 64 * AT_VP;
constexpr int AT_BIAS_OFF = 122880;
NI void attn_unit(LAS unsigned char* lds, const bf16_t* z_, bf16_t* mixed_, int b_, int h_, int qb_, float lam_, float outscale_, const float* normg_, unsigned long long& tp_t0, unsigned long long& tp_acc) {
    const bf16_t* const z = uni(z_); bf16_t* const mixed = uni(mixed_); const int b = rfl(b_), h = rfl(h_), qb = rfl(qb_); const float lam = unif(lam_), outscale = unif(outscale_); const float* const normg = uni(normg_);
    const int tid = opaque_tid(), lane = tid & 63, w = rfl(tid >> 6), r = lane & 31, hh = lane >> 5;
    const int map = w & 1, qsub = w >> 1;
    const int q0 = qb * 128;
    const size_t rowbase = (size_t)b * SEQ;
    const int NT = (q0 + 128) / 64;
    const LAS float* biasT = (const LAS float*)(lds + AT_BIAS_OFF) + h * 128;
    const int qpos = q0 + 32 * qsub + r;
    const float C2 = 0.125f * LOG2E;
    bf16x8 qf[4];
    { const bf16_t* qrow = z + (rowbase + qpos) * ZW + ZC_DQ + h * 128 + map * 64 + 8 * hh;
#pragma unroll
      for (int ds = 0; ds < 4; ++ds) { u32x4 raw = *(const u32x4*)(qrow + 16 * ds);
          raw.x = pk2(bflo(raw.x) * C2, bfhi(raw.x) * C2); raw.y = pk2(bflo(raw.y) * C2, bfhi(raw.y) * C2); raw.z = pk2(bflo(raw.z) * C2, bfhi(raw.z) * C2); raw.w = pk2(bflo(raw.w) * C2, bfhi(raw.w) * C2);
          qf[ds] = __builtin_bit_cast(bf16x8, raw); } }
    const bf16_t* kg = z + (rowbase + (tid >> 4)) * ZW + ZC_DK + h * 128 + (tid & 15) * 8;
    const bf16_t* vg = z + (rowbase + (tid >> 4)) * ZW + ZC_DV + h * 128 + (tid & 15) * 8;
    const int kdst = (tid >> 4) * AT_KP + (tid & 15) * 16, vdst = 2 * AT_KB + (tid >> 4) * AT_VP + (tid & 15) * 16;
    const bool typeB = (w >= 4);
    u32x4 kr0, kr1, vr0, vr1;
    kr0 = *(const u32x4*)(kg); kr1 = *(const u32x4*)(kg + (size_t)32 * ZW); vr0 = *(const u32x4*)(vg); vr1 = *(const u32x4*)(vg + (size_t)32 * ZW);
    *(LAS u32x4*)(lds + kdst) = kr0; *(LAS u32x4*)(lds + kdst + 32 * AT_KP) = kr1; *(LAS u32x4*)(lds + vdst) = vr0; *(LAS u32x4*)(lds + vdst + 32 * AT_VP) = vr1;
    __syncthreads();
    f32x16 O[4];
#pragma unroll
    for (int et = 0; et < 4; ++et) O[et] = zero16();
    float m_run = 0.f, l_run = 0.f;
    const float bias_far = biasT[127];
    float nm = bias_far;
    bf16x8 pq0, pq1, pq2, pq3; bool prev_active = false; int vs_cur = 0, vs_prev = 0;
    pq0 = pq1 = pq2 = pq3 = (bf16x8){0, 0, 0, 0, 0, 0, 0, 0};
#define ATT_MFMA_T(acc_, a_, b_) acc_ = MFMA32((a_), (b_), acc_)
#define ATT_PV(Vb_, q0_, q1_, q2_, q3_) do { bf16x8 vf[4]; \
        _Pragma("unroll") for (int et = 0; et < 4; ++et) { \
            _Pragma("unroll") for (int ks = 0; ks < 4; ++ks) vf[ks] = frag_tr((Vb_), AT_VP, 16 * ks + 4 * hh, 16 * ks + 8 + 4 * hh, 32 * et, lane); \
            __builtin_amdgcn_sched_barrier(0); \
            ATT_MFMA_T(O[et], vf[0], (q0_)); ATT_MFMA_T(O[et], vf[1], (q1_)); \
            ATT_MFMA_T(O[et], vf[2], (q2_)); ATT_MFMA_T(O[et], vf[3], (q3_)); \
            __builtin_amdgcn_sched_barrier(0); } } while (0)
#define ATT_LOOP(TB) do { \
    for (int t = 0; t < NT; ++t) { \
        const bool more = (t + 1 < NT); \
        if ((TB) && prev_active) ATT_PV(lds + 2 * AT_KB + vs_prev * AT_VB, pq0, pq1, pq2, pq3); \
        if (more) { const size_t go = (size_t)(t + 1) * 64 * ZW; kr0 = *(const u32x4*)(kg + go); kr1 = *(const u32x4*)(kg + go + (size_t)32 * ZW); vr0 = *(const u32x4*)(vg + go); vr1 = *(const u32x4*)(vg + go + (size_t)32 * ZW); } \
        const bool active = (64 * t <= q0 + 32 * qsub + 31); \
        if (active) { \
            const LAS unsigned char* Kb = lds + (t & 1) * AT_KB; const LAS unsigned char* Vb = lds + 2 * AT_KB + vs_cur * AT_VB; \
            const bool near = (t >= NT - 4); \
            f32x16 p0, p1; \
            { bf16x8 ka[4][2]; \
_Pragma("unroll") \
              for (int ds = 0; ds < 4; ++ds) { const int kbyte = (map * 64 + 16 * ds + 8 * hh) * 2; ka[ds][0] = frag_row(Kb, AT_KP, r, kbyte); ka[ds][1] = frag_row(Kb, AT_KP, 32 + r, kbyte); } \
              __builtin_amdgcn_sched_barrier(0); \
              p0 = splat16(nm); p1 = p0; \
_Pragma("unroll") \
              for (int ds = 0; ds < 4; ++ds) { p0 = MFMA32(ka[ds][0], qf[ds], p0); p1 = MFMA32(ka[ds][1], qf[ds], p1); } } \
            if (near) { \
                asm volatile("" ::: "memory"); \
                float b0[16], b1[16]; \
_Pragma("unroll") \
                for (int reg = 0; reg < 16; ++reg) { const int n0 = qpos - (64 * t + crow(reg, hh)), n1 = n0 - 32; \
                    b0[reg] = biasT[n0 > 127 ? 127 : (n0 < 0 ? 0 : n0)]; b1[reg] = biasT[n1 > 127 ? 127 : (n1 < 0 ? 0 : n1)]; } \
_Pragma("unroll") \
                for (int reg = 0; reg < 16; ++reg) { const int n0 = qpos - (64 * t + crow(reg, hh)), n1 = n0 - 32; \
                    p0[reg] = n0 < 0 ? -1e30f : p0[reg] + (b0[reg] - bias_far); \
                    p1[reg] = n1 < 0 ? -1e30f : p1[reg] + (b1[reg] - bias_far); } \
            } \
            float mx = fmaxf(p0[0], p1[0]); \
_Pragma("unroll") \
            for (int reg = 1; reg < 16; ++reg) mx = fmaxf(fmaxf(mx, p0[reg]), p1[reg]); \
            { const auto rr = __builtin_amdgcn_permlane32_swap(__float_as_uint(mx), __float_as_uint(mx), false, false); mx = fmaxf(__uint_as_float(rr[0]), __uint_as_float(rr[1])); } \
            if (t == 0 || !__all(mx <= 8.0f)) { \
                asm volatile("" ::: "memory"); \
                const float delta = (t == 0) ? mx : fmaxf(mx, 0.f); \
                m_run += delta; const float sc = __builtin_amdgcn_exp2f(-delta); \
                l_run *= sc; \
_Pragma("unroll") \
                for (int et = 0; et < 4; ++et) O[et] = O[et] * sc; \
                nm -= delta; \
_Pragma("unroll") \
                for (int reg = 0; reg < 16; ++reg) { p0[reg] -= delta; p1[reg] -= delta; } \
            } \
            f32x2 ps2 = {0.f, 0.f}; \
_Pragma("unroll") \
            for (int reg = 0; reg < 16; ++reg) { p0[reg] = __builtin_amdgcn_exp2f(p0[reg]); p1[reg] = __builtin_amdgcn_exp2f(p1[reg]); ps2 = ps2 + (f32x2){p0[reg], p1[reg]}; } \
            l_run += ps2[0] + ps2[1]; \
            const bf16x8 pb00 = pack8<0>(p0), pb01 = pack8<1>(p0), pb10 = pack8<0>(p1), pb11 = pack8<1>(p1); \
            if (!(TB)) ATT_PV(Vb, pb00, pb01, pb10, pb11); \
            else { pq0 = pb00; pq1 = pb01; pq2 = pb10; pq3 = pb11; } \
        } \
        prev_active = active; vs_prev = vs_cur; const int vs_next = (vs_cur == 2) ? 0 : vs_cur + 1; \
        if (PROBE_ID == 28 && blockIdx.x == 64) { asm volatile("s_waitcnt lgkmcnt(0)" ::: "memory"); tp_t0 = __builtin_amdgcn_s_memrealtime(); asm volatile("s_waitcnt lgkmcnt(0)" ::: "memory"); } \
        if (more) { const int bo = ((t + 1) & 1); *(LAS u32x4*)(lds + bo * AT_KB + kdst) = kr0; *(LAS u32x4*)(lds + bo * AT_KB + kdst + 32 * AT_KP) = kr1; \
            *(LAS u32x4*)(lds + vs_next * AT_VB + vdst) = vr0; *(LAS u32x4*)(lds + vs_next * AT_VB + vdst + 32 * AT_VP) = vr1; } \
        vs_cur = vs_next; \
        if (PROBE_ID == 28 && blockIdx.x == 64) { asm volatile("s_waitcnt vmcnt(0) lgkmcnt(0)" ::: "memory"); tp_acc += __builtin_amdgcn_s_memrealtime() - tp_t0; } \
        __syncthreads(); \
    } \
    } while (0)
    if (typeB) ATT_LOOP(1); else ATT_LOOP(0);
#undef ATT_LOOP
    if (typeB && prev_active) ATT_PV(lds + 2 * AT_KB + vs_prev * AT_VB, pq0, pq1, pq2, pq3);
#undef ATT_PV
#undef ATT_MFMA_T
    __syncthreads();

    const float l_tot = swap32_sum(l_run, l_run); const float inv = 1.0f / l_tot;
    LAS float* xch = (LAS float*)lds + qsub * 4096;
    if (map == 1) { const float sc = inv * lam;
#pragma unroll
        for (int et = 0; et < 4; ++et)
#pragma unroll
            for (int reg = 0; reg < 16; ++reg) xch[(et * 16 + reg) * 64 + lane] = O[et][reg] * sc; }
    __syncthreads();
    if (map == 0) { float ss = 0.f;
#pragma unroll
        for (int et = 0; et < 4; ++et)
#pragma unroll
            for (int reg = 0; reg < 16; ++reg) { const float d = O[et][reg] * inv - xch[(et * 16 + reg) * 64 + lane]; O[et][reg] = d; ss += d * d; }
        ss += __shfl_xor(ss, 32);
        const float rn = __builtin_amdgcn_rsqf(ss * (1.0f / 128.0f) + HN_EPS) * outscale;
        bf16_t* orow = mixed + (rowbase + qpos) * DM + 256 + h * 128;
#pragma unroll
        for (int et = 0; et < 4; ++et)
#pragma unroll
            for (int rg = 0; rg < 4; ++rg) { const int e0 = 32 * et + 8 * rg + 4 * hh; const f32x4 g4 = *(const f32x4*)(normg + e0);
#if F8_OUT
                *(unsigned*)((unsigned char*)mixed + (rowbase + qpos) * DM + 256 + h * 128 + e0) = pk4_fp8(O[et][4 * rg] * rn * g4[0], O[et][4 * rg + 1] * rn * g4[1], O[et][4 * rg + 2] * rn * g4[2], O[et][4 * rg + 3] * rn * g4[3]); } }
#else
                u32x2 o; o.x = pk2(O[et][4 * rg] * rn * g4[0], O[et][4 * rg + 1] * rn * g4[1]); o.y = pk2(O[et][4 * rg + 2] * rn * g4[2], O[et][4 * rg + 3] * rn * g4[3]);
                *(u32x2*)(orow + e0) = o; } }
#endif
    __syncthreads();
}

template <int C, int DK, bool GLA>
NI void stream_run(LAS unsigned char* lds, unsigned char* ws_, const float* wg_, const float* bg_, const float* ngain_, int sidx_, int b_, int h_) {
    unsigned char* const ws = uni(ws_); const float* const wgL = uni(wg_); const float* const bgL = uni(bg_); const float* const ngain = uni(ngain_); const int sidx = rfl(sidx_), b = rfl(b_), h = rfl(h_);
    constexpr int PQ = DK * 2 + 16, PV = 192, NC = SEQ / C;
    constexpr int OFF_Q = 0, OFF_K = C * PQ, OFF_V = 2 * C * PQ, OFF_ST = 2 * C * PQ + C * PV, ST_BYTES = 64 * PQ;
    constexpr int NQ = C * DK / 8;
    constexpr int NQK = (2 * NQ) / 512 > 0 ? (2 * NQ) / 512 : 1, NVP = (C * 8) / 512;
    constexpr int NTT = C / 32, NKS = DK / 16;
    const int tid = opaque_tid(), lane = tid & 63, w = rfl(tid >> 6), r = lane & 31, hh = lane >> 5;
    const size_t rowbase = (size_t)b * SEQ;
    const bf16_t* z = (const bf16_t*)(ws + WS_Z);
    bf16_t* mixed = (bf16_t*)(ws + WS_MIX);
    unsigned char* gs = ws + WS_GS + (size_t)sidx * GS_STRIDE;
    bf16_t* QP = (bf16_t*)gs; bf16_t* KP = (bf16_t*)(gs + 512 * 1024); float* DG = (float*)(gs + MiB);
    const int zq = GLA ? ZC_GQ + h * 32 : ZC_RQ + h * 64, zk = GLA ? ZC_GK + h * 32 : ZC_RK + h * 64, zv = GLA ? ZC_GV + h * 64 : ZC_RV + h * 64, zg = GLA ? ZC_GO + h * 64 : ZC_RG + h * 64;
    const int mcol = GLA ? h * 64 : 768 + h * 64;
    const float l2g_tab[4] = {-0.04580368961312479f, -0.02272007650008353f, -0.011315313227834146f, -0.005646563141142063f};
    const float log2g = h == 0 ? l2g_tab[0] : h == 1 ? l2g_tab[1] : h == 2 ? l2g_tab[2] : l2g_tab[3];
    if constexpr (GLA) {
        const float* wg = wgL + h * 32; const float* bg = bgL + h * 32;
        LAS float* wl = (LAS float*)(lds + 65536);
        wl[tid] = wg[(tid >> 5) * 128 + (tid & 31)];
        if (tid < 32) wl[512 + tid] = bg[tid];
        __syncthreads();
        for (int chunk = w; chunk < NC; chunk += 8) {
            const size_t trow = (size_t)chunk * C + lane; const bf16_t* zr = z + (rowbase + trow) * ZW;
            const u32x4 g0 = *(const u32x4*)(zr + ZC_LR), g1 = *(const u32x4*)(zr + ZC_LR + 8);
            u32x4 qv[4], kv[4];
#pragma unroll
            for (int j = 0; j < 4; ++j) { qv[j] = *(const u32x4*)(zr + zq + 8 * j); kv[j] = *(const u32x4*)(zr + zk + 8 * j); }
            const float gl[16] = {bflo(g0.x), bfhi(g0.x), bflo(g0.y), bfhi(g0.y), bflo(g0.z), bfhi(g0.z), bflo(g0.w), bfhi(g0.w),
                                  bflo(g1.x), bfhi(g1.x), bflo(g1.y), bfhi(g1.y), bflo(g1.z), bfhi(g1.z), bflo(g1.w), bfhi(g1.w)};
            u32x4 qo[4], ko[4];
#pragma unroll
            for (int c4 = 0; c4 < 8; ++c4) {
                f32x4 x = *(const LAS f32x4*)(wl + 512 + 4 * c4);
#pragma unroll
                for (int rr = 0; rr < 16; ++rr) x = x + *(const LAS f32x4*)(wl + rr * 32 + 4 * c4) * gl[rr];
                float qn[4], kn[4];
#pragma unroll
                for (int i = 0; i < 4; ++i) {
                    float v = (fminf(x[i], 0.f) - __logf(1.f + __expf(-fabsf(x[i])))) * (1.0f / 16.0f);
#pragma unroll
                    for (int o = 1; o < 64; o <<= 1) { const float tup = __shfl_up(v, o); v += (lane >= o) ? tup : 0.f; }
                    const unsigned qw = qv[c4 >> 1][(c4 & 1) * 2 + (i >> 1)], kw = kv[c4 >> 1][(c4 & 1) * 2 + (i >> 1)];
                    const float qe = (i & 1) ? bfhi(qw) : bflo(qw), ke = (i & 1) ? bfhi(kw) : bflo(kw);
                    const float eq = __expf(v);
                    qn[i] = qe * eq * 0.17677669529663687f; kn[i] = ke * __expf(-v);
                    if (lane == 63) DG[chunk * 32 + 4 * c4 + i] = eq;
                }
                qo[c4 >> 1][(c4 & 1) * 2] = pk2(qn[0], qn[1]); qo[c4 >> 1][(c4 & 1) * 2 + 1] = pk2(qn[2], qn[3]);
                ko[c4 >> 1][(c4 & 1) * 2] = pk2(kn[0], kn[1]); ko[c4 >> 1][(c4 & 1) * 2 + 1] = pk2(kn[2], kn[3]);
            }
#pragma unroll
            for (int j = 0; j < 4; ++j) { *(u32x4*)(QP + trow * DK + 8 * j) = qo[j]; *(u32x4*)(KP + trow * DK + 8 * j) = ko[j]; }
        }
    } else {
        const f32x4* sct = (const f32x4*)(ws + WS_SINCOS);
        for (int it0 = tid; it0 < SEQ * 8; it0 += 4 * 512) {
            u32x4 q4[4], k4[4]; f32x4 s0[4], s1[4];
#pragma unroll
            for (int u = 0; u < 4; ++u) { const int it = it0 + u * 512, t = it >> 3, j = it & 7; const bf16_t* zr = z + (rowbase + t) * ZW;
                q4[u] = *(const u32x4*)(zr + zq + 8 * j); k4[u] = *(const u32x4*)(zr + zk + 8 * j); s0[u] = sct[t * 16 + 2 * j]; s1[u] = sct[t * 16 + 2 * j + 1]; }
#pragma unroll
            for (int u = 0; u < 4; ++u) { const int it = it0 + u * 512, t = it >> 3, j = it & 7;
                const float e = (float)((t & (C - 1)) + 1) * log2g; const float dq = __builtin_amdgcn_exp2f(e), dk = 0.125f * __builtin_amdgcn_exp2f(-e);
                u32x4 qo, ko;
#pragma unroll
                for (int pi = 0; pi < 4; ++pi) { const float sn = pi == 0 ? s0[u][0] : pi == 1 ? s0[u][2] : pi == 2 ? s1[u][0] : s1[u][2], cs = pi == 0 ? s0[u][1] : pi == 1 ? s0[u][3] : pi == 2 ? s1[u][1] : s1[u][3];
                    const float qa = bflo(q4[u][pi]), qb_ = bfhi(q4[u][pi]), ka = bflo(k4[u][pi]), kb_ = bfhi(k4[u][pi]);
                    qo[pi] = pk2((qa * cs - qb_ * sn) * dq, (qb_ * cs + qa * sn) * dq); ko[pi] = pk2((ka * cs - kb_ * sn) * dk, (kb_ * cs + ka * sn) * dk); }
                *(u32x4*)(QP + (size_t)t * DK + 8 * j) = qo; *(u32x4*)(KP + (size_t)t * DK + 8 * j) = ko; }
        }
    }
    for (int i = tid; i < ST_BYTES / 4; i += 512) ((LAS unsigned*)(lds + OFF_ST))[i] = 0u;
    __syncthreads();
    u32x4 rqk[NQK], rv[NVP];
#define ISSUE_LOADS(ci_) do { \
    _Pragma("unroll") for (int j = 0; j < NQK; ++j) { const int idx = tid + 512 * j; \
        if (idx < 2 * NQ) { const bool isk = idx >= NQ; const int id = isk ? idx - NQ : idx; rqk[j] = *(const u32x4*)((isk ? KP : QP) + (size_t)(ci_) * C * DK + (size_t)id * 8); } } \
    _Pragma("unroll") for (int j = 0; j < NVP; ++j) { const int idx = tid + 512 * j, row = idx >> 3, ch = idx & 7; rv[j] = *(const u32x4*)(z + (rowbase + (size_t)(ci_) * C + row) * ZW + zv + ch * 8); } \
    } while (0)
    ISSUE_LOADS(0);
    f32x16 Sacc = zero16();
    const float gC = __builtin_amdgcn_exp2f((float)C * log2g);
    for (int ci = 0; ci < NC; ++ci) {
        __syncthreads();
#pragma unroll
        for (int j = 0; j < NQK; ++j) { const int idx = tid + 512 * j;
            if (idx < 2 * NQ) { const bool isk = idx >= NQ; const int id = isk ? idx - NQ : idx; const int row = id / (DK / 8), ch = id % (DK / 8);
                *(LAS u32x4*)(lds + (isk ? OFF_K : OFF_Q) + row * PQ + ch * 16) = rqk[j]; } }
#pragma unroll
        for (int j = 0; j < NVP; ++j) { const int idx = tid + 512 * j, row = idx >> 3, ch = idx & 7; *(LAS u32x4*)(lds + OFF_V + row * PV + ch * 16) = rv[j]; }
        __syncthreads();
        if (ci + 1 < NC) ISSUE_LOADS(ci + 1);
        const LAS unsigned char* Ql = lds + OFF_Q; const LAS unsigned char* Kl = lds + OFF_K; const LAS unsigned char* Vl = lds + OFF_V;
        const LAS unsigned char* STr = lds + OFF_ST + (ci & 1) * ST_BYTES; LAS unsigned char* STw = lds + OFF_ST + ((ci + 1) & 1) * ST_BYTES;
        if (w < NTT) {
            const int tt = w;
            u32x2 gtv[2][4];
            { const bf16_t* grow_ = z + (rowbase + (size_t)ci * C + 32 * tt + r) * ZW + zg;
#pragma unroll
              for (int vt = 0; vt < 2; ++vt)
#pragma unroll
                  for (int rg = 0; rg < 4; ++rg) gtv[vt][rg] = *(const u32x2*)(grow_ + 32 * vt + 8 * rg + 4 * hh); }
            __builtin_amdgcn_sched_barrier(0);
            bf16x8 bq[NKS];
#pragma unroll
            for (int ks = 0; ks < NKS; ++ks) bq[ks] = frag_row(Ql, PQ, 32 * tt + r, (16 * ks + 8 * hh) * 2);
            f32x16 o0 = zero16(), o1 = zero16();
#pragma unroll
            for (int st = 0; st < NTT; ++st) {
                if (st <= tt) {
                    f32x16 Xs = zero16();
#pragma unroll
                    for (int ks = 0; ks < NKS; ++ks) Xs = MFMA32(frag_row(Kl, PQ, 32 * st + r, (16 * ks + 8 * hh) * 2), bq[ks], Xs);
                    if (st == tt) {
#pragma unroll
                        for (int reg = 0; reg < 16; ++reg) if (crow(reg, hh) > r) Xs[reg] = 0.f;
                    }
                    const bf16x8 x0 = pack8<0>(Xs), x1 = pack8<1>(Xs);
                    o0 = MFMA32(frag_tr(Vl, PV, 32 * st + 4 * hh, 32 * st + 8 + 4 * hh, 0, lane), x0, o0);
                    o1 = MFMA32(frag_tr(Vl, PV, 32 * st + 4 * hh, 32 * st + 8 + 4 * hh, 32, lane), x0, o1);
                    o0 = MFMA32(frag_tr(Vl, PV, 32 * st + 16 + 4 * hh, 32 * st + 24 + 4 * hh, 0, lane), x1, o0);
                    o1 = MFMA32(frag_tr(Vl, PV, 32 * st + 16 + 4 * hh, 32 * st + 24 + 4 * hh, 32, lane), x1, o1);
                }
            }
#pragma unroll
            for (int ks = 0; ks < NKS; ++ks) { const int kbyte = (16 * ks + 8 * hh) * 2;
                o0 = MFMA32(frag_row(STr, PQ, r, kbyte), bq[ks], o0); o1 = MFMA32(frag_row(STr, PQ, 32 + r, kbyte), bq[ks], o1); }
            float ss = 0.f;
#pragma unroll
            for (int reg = 0; reg < 16; ++reg) ss += o0[reg] * o0[reg] + o1[reg] * o1[reg];
            ss += __shfl_xor(ss, 32);
            const float rn = __builtin_amdgcn_rsqf(ss * (1.0f / 64.0f) + HN_EPS);
            const size_t row = rowbase + (size_t)ci * C + 32 * tt + r;
            const bf16_t* grow = z + row * ZW + zg; bf16_t* orow = mixed + row * DM + mcol;
#pragma unroll
            for (int vt = 0; vt < 2; ++vt)
#pragma unroll
                for (int rg = 0; rg < 4; ++rg) { const int v0 = 32 * vt + 8 * rg + 4 * hh; const u32x2 gt2 = gtv[vt][rg];
                    float gv[4] = {bflo(gt2.x), bfhi(gt2.x), bflo(gt2.y), bfhi(gt2.y)}; float res[4];
                    f32x4 gn = {1.f, 1.f, 1.f, 1.f}; if constexpr (GLA) gn = *(const f32x4*)(ngain + v0);
#pragma unroll
                    for (int i = 0; i < 4; ++i) { const float ov = (vt == 0 ? o0[4 * rg + i] : o1[4 * rg + i]) * rn * gn[i]; res[i] = ov * gv[i] * sigmoidf_(gv[i]); }
#if F8_OUT
                    *(unsigned*)((unsigned char*)mixed + row * DM + mcol + v0) = pk4_fp8(res[0], res[1], res[2], res[3]); }
#else
                    u32x2 o; o.x = pk2(res[0], res[1]); o.y = pk2(res[2], res[3]); *(u32x2*)(orow + v0) = o; }
#endif
        } else if (w < NTT + 2 * (DK / 32)) {
            const int kw = w - NTT, vt = kw & 1, ct = kw >> 1;
#pragma unroll
            for (int k2 = 0; k2 < C / 16; ++k2) { const int kb = 16 * k2 + 8 * hh;
                Sacc = MFMA32(frag_tr(Vl, PV, kb, kb + 4, 32 * vt, lane), frag_tr(Kl, PQ, kb, kb + 4, 32 * ct, lane), Sacc); }
            float d; if constexpr (GLA) d = DG[ci * 32 + r]; else d = gC;
#pragma unroll
            for (int reg = 0; reg < 16; ++reg) { Sacc[reg] *= d; *(LAS bf16_t*)(STw + (32 * vt + crow(reg, hh)) * PQ + (32 * ct + r) * 2) = f2bf(Sacc[reg]); }
        }
    }
    __syncthreads();
#undef ISSUE_LOADS
}

DI void gla_stream3(LAS unsigned char* lds, unsigned char* ws_, const float* wg_, const float* bg_, const float* ngain_, int sidx_, int b_, int h_, unsigned long long& tp_t0, unsigned long long& tp_acc) {
    constexpr int C = 64, DK = 32, NC = SEQ / C, PV = 192;
    unsigned char* const ws = uni(ws_); const float* const wgL = uni(wg_); const float* const bgL = uni(bg_); const float* const ngain = uni(ngain_); const int sidx = rfl(sidx_), b = rfl(b_), h = rfl(h_);
    const int tid = opaque_tid(), lane = tid & 63, w = rfl(tid >> 6), r = lane & 31, hh = lane >> 5;
    const size_t rowbase = (size_t)b * SEQ;
    const bf16_t* z = (const bf16_t*)(ws + WS_Z);
    bf16_t* mixed = (bf16_t*)(ws + WS_MIX);
    unsigned char* gs = ws + WS_GS + (size_t)sidx * GS_STRIDE;
    bf16_t* QP = (bf16_t*)gs; bf16_t* KP = (bf16_t*)(gs + 256 * 1024); bf16_t* KPT = (bf16_t*)(gs + 512 * 1024); bf16_t* STs = (bf16_t*)(gs + 768 * 1024);
    float* KVs = (float*)(gs + MiB); float* DG = (float*)(gs + MiB + 512 * 1024);
    const int zq = ZC_GQ + h * 32, zk = ZC_GK + h * 32, zv = ZC_GV + h * 64, zg = ZC_GO + h * 64, mcol = h * 64;
    TP_BEGIN(24);
    {
        const float* wg = wgL + h * 32; const float* bg = bgL + h * 32;
        LAS float* wl = (LAS float*)(lds + 100 * 1024);
        wl[tid] = wg[(tid >> 5) * 128 + (tid & 31)];
        if (tid < 32) wl[512 + tid] = bg[tid];
        __syncthreads();
        for (int chunk = w; chunk < NC; chunk += 8) {
            const size_t trow = (size_t)chunk * C + lane; const bf16_t* zr = z + (rowbase + trow) * ZW;
            const u32x4 g0 = *(const u32x4*)(zr + ZC_LR), g1 = *(const u32x4*)(zr + ZC_LR + 8);
            u32x4 qv[4], kv[4];
#pragma unroll
            for (int j = 0; j < 4; ++j) { qv[j] = *(const u32x4*)(zr + zq + 8 * j); kv[j] = *(const u32x4*)(zr + zk + 8 * j); }
            const float gl[16] = {bflo(g0.x), bfhi(g0.x), bflo(g0.y), bfhi(g0.y), bflo(g0.z), bfhi(g0.z), bflo(g0.w), bfhi(g0.w),
                                  bflo(g1.x), bfhi(g1.x), bflo(g1.y), bfhi(g1.y), bflo(g1.z), bfhi(g1.z), bflo(g1.w), bfhi(g1.w)};
            u32x4 qo[4], ko[4]; float dgv = 0.f;
#pragma unroll
            for (int c4 = 0; c4 < 8; ++c4) {
                f32x4 x = *(const LAS f32x4*)(wl + 512 + 4 * c4);
#pragma unroll
                for (int rr = 0; rr < 16; ++rr) x = x + *(const LAS f32x4*)(wl + rr * 32 + 4 * c4) * gl[rr];
                float qn[4], kn[4];
#pragma unroll
                for (int i = 0; i < 4; ++i) {
                    float v = (fminf(x[i], 0.f) - __logf(1.f + __expf(-fabsf(x[i])))) * (1.0f / 16.0f);
                    v = wave_incl_scan(v);
                    const unsigned qw = qv[c4 >> 1][(c4 & 1) * 2 + (i >> 1)], kw = kv[c4 >> 1][(c4 & 1) * 2 + (i >> 1)];
                    const float qe = (i & 1) ? bfhi(qw) : bflo(qw), ke = (i & 1) ? bfhi(kw) : bflo(kw);
                    const float eq = __expf(v);
                    qn[i] = qe * eq * 0.17677669529663687f; kn[i] = ke * __expf(-v);
                    { const float e63 = __int_as_float(__builtin_amdgcn_readlane(__float_as_int(eq), 63)); dgv = (lane == 4 * c4 + i) ? e63 : dgv; }
                    KPT[((size_t)chunk * 32 + 4 * c4 + i) * 64 + lane] = f2bf(kn[i]);
                }
                qo[c4 >> 1][(c4 & 1) * 2] = pk2(qn[0], qn[1]); qo[c4 >> 1][(c4 & 1) * 2 + 1] = pk2(qn[2], qn[3]);
                ko[c4 >> 1][(c4 & 1) * 2] = pk2(kn[0], kn[1]); ko[c4 >> 1][(c4 & 1) * 2 + 1] = pk2(kn[2], kn[3]);
                __builtin_amdgcn_sched_barrier(0);
            }
#pragma unroll
            for (int j = 0; j < 4; ++j) { *(u32x4*)(QP + trow * DK + 8 * j) = qo[j]; *(u32x4*)(KP + trow * DK + 8 * j) = ko[j]; }
            if (lane < 32) DG[chunk * 32 + lane] = dgv;
        }
    }
    __syncthreads();
    TP_END(24); TP_BEGIN(25);
    LAS unsigned char* Vw = lds + w * (64 * PV);
#define GLA_LOAD_V(chunk_) do { u32x4 vt_[8]; \
        _Pragma("unroll") for (int j = 0; j < 8; ++j) { const int idx = lane + 64 * j; vt_[j] = *(const u32x4*)(z + (rowbase + (size_t)(chunk_) * C + (idx >> 3)) * ZW + zv + (idx & 7) * 8); } \
        _Pragma("unroll") for (int j = 0; j < 8; ++j) { const int idx = lane + 64 * j; *(LAS u32x4*)(Vw + (idx >> 3) * PV + (idx & 7) * 16) = vt_[j]; } } while (0)
    for (int chunk = w; chunk < NC; chunk += 8) {
        GLA_LOAD_V(chunk);
        bf16x8 ka[4];
#pragma unroll
        for (int ks = 0; ks < 4; ++ks) ka[ks] = *(const bf16x8*)(KPT + ((size_t)chunk * 32 + r) * 64 + 16 * ks + 8 * hh);
        f32x16 a0 = zero16(), a1 = zero16();
#pragma unroll
        for (int ks = 0; ks < 4; ++ks) { const int kb = 16 * ks + 8 * hh;
            a0 = MFMA32(ka[ks], frag_tr(Vw, PV, kb, kb + 4, 0, lane), a0); a1 = MFMA32(ka[ks], frag_tr(Vw, PV, kb, kb + 4, 32, lane), a1); }
#pragma unroll
        for (int rg = 0; rg < 4; ++rg) { const int c0 = 8 * rg + 4 * hh;
            *(f32x4*)(KVs + ((size_t)chunk * 64 + r) * 32 + c0) = (f32x4){a0[4 * rg], a0[4 * rg + 1], a0[4 * rg + 2], a0[4 * rg + 3]};
            *(f32x4*)(KVs + ((size_t)chunk * 64 + 32 + r) * 32 + c0) = (f32x4){a1[4 * rg], a1[4 * rg + 1], a1[4 * rg + 2], a1[4 * rg + 3]}; }
    }
    __syncthreads();
    TP_END(25); TP_BEGIN(26);
    { const int v = tid >> 3, c0 = (tid & 7) * 4; f32x4 S = {0.f, 0.f, 0.f, 0.f};
      for (int cb = 0; cb < NC; cb += 8) { f32x4 kvv[8], dd[8];
#pragma unroll
          for (int u = 0; u < 8; ++u) { kvv[u] = *(const f32x4*)(KVs + ((size_t)(cb + u) * 64 + v) * 32 + c0); dd[u] = *(const f32x4*)(DG + (cb + u) * 32 + c0); }
#pragma unroll
          for (int u = 0; u < 8; ++u) { u32x2 o; o.x = pk2(S[0], S[1]); o.y = pk2(S[2], S[3]); *(u32x2*)(STs + ((size_t)(cb + u) * 64 + v) * 32 + c0) = o; S = dd[u] * (S + kvv[u]); } } }
    __syncthreads();
    TP_END(26); TP_BEGIN(27);
    f32x4 gnv[2][4];
#pragma unroll
    for (int vt = 0; vt < 2; ++vt)
#pragma unroll
        for (int rg = 0; rg < 4; ++rg) gnv[vt][rg] = *(const f32x4*)(ngain + 32 * vt + 8 * rg + 4 * hh);
    for (int chunk = w; chunk < NC; chunk += 8) {
        GLA_LOAD_V(chunk);
        bf16x8 kf[2][2], sf[2][2], bq[2][2];
#pragma unroll
        for (int a = 0; a < 2; ++a)
#pragma unroll
            for (int ks = 0; ks < 2; ++ks) { const size_t ro = ((size_t)chunk * 64 + 32 * a + r) * 32 + 16 * ks + 8 * hh;
                kf[a][ks] = *(const bf16x8*)(KP + ro); sf[a][ks] = *(const bf16x8*)(STs + ro); bq[a][ks] = *(const bf16x8*)(QP + ro); }
#pragma unroll
        for (int tt = 0; tt < 2; ++tt) {
            f32x16 o0 = zero16(), o1 = zero16();
            u32x2 gtv[2][4];
            { const bf16_t* grow_ = z + (rowbase + (size_t)chunk * C + 32 * tt + r) * ZW + zg;
#pragma unroll
              for (int vt = 0; vt < 2; ++vt)
#pragma unroll
                  for (int rg = 0; rg < 4; ++rg) gtv[vt][rg] = *(const u32x2*)(grow_ + 32 * vt + 8 * rg + 4 * hh); }
            __builtin_amdgcn_sched_barrier(0);
#pragma unroll
            for (int st = 0; st <= tt; ++st) {
                f32x16 Xs = zero16();
#pragma unroll
                for (int ks = 0; ks < 2; ++ks) Xs = MFMA32(kf[st][ks], bq[tt][ks], Xs);
                if (st == tt) {
#pragma unroll
                    for (int reg = 0; reg < 16; ++reg) if (crow(reg, hh) > r) Xs[reg] = 0.f;
                }
                const bf16x8 x0 = pack8<0>(Xs), x1 = pack8<1>(Xs);
                o0 = MFMA32(frag_tr(Vw, PV, 32 * st + 4 * hh, 32 * st + 8 + 4 * hh, 0, lane), x0, o0);
                o1 = MFMA32(frag_tr(Vw, PV, 32 * st + 4 * hh, 32 * st + 8 + 4 * hh, 32, lane), x0, o1);
                o0 = MFMA32(frag_tr(Vw, PV, 32 * st + 16 + 4 * hh, 32 * st + 24 + 4 * hh, 0, lane), x1, o0);
                o1 = MFMA32(frag_tr(Vw, PV, 32 * st + 16 + 4 * hh, 32 * st + 24 + 4 * hh, 32, lane), x1, o1);
            }
#pragma unroll
            for (int ks = 0; ks < 2; ++ks) { o0 = MFMA32(sf[0][ks], bq[tt][ks], o0); o1 = MFMA32(sf[1][ks], bq[tt][ks], o1); }
            float ss = 0.f;
#pragma unroll
            for (int reg = 0; reg < 16; ++reg) ss += o0[reg] * o0[reg] + o1[reg] * o1[reg];
            ss += __shfl_xor(ss, 32);
            const float rn = __builtin_amdgcn_rsqf(ss * (1.0f / 64.0f) + HN_EPS);
            const size_t row = rowbase + (size_t)chunk * C + 32 * tt + r;
            const bf16_t* grow = z + row * ZW + zg; bf16_t* orow = mixed + row * DM + mcol;
#pragma unroll
            for (int vt = 0; vt < 2; ++vt)
#pragma unroll
                for (int rg = 0; rg < 4; ++rg) { const int v0 = 32 * vt + 8 * rg + 4 * hh; const u32x2 gt2 = gtv[vt][rg];
                    const float gv[4] = {bflo(gt2.x), bfhi(gt2.x), bflo(gt2.y), bfhi(gt2.y)}; float res[4];
                    const f32x4 gn = gnv[vt][rg];
#pragma unroll
                    for (int i = 0; i < 4; ++i) { const float ov = (vt == 0 ? o0[4 * rg + i] : o1[4 * rg + i]) * rn * gn[i]; res[i] = ov * gv[i] * sigmoidf_(gv[i]); }
#if F8_OUT
                    *(unsigned*)((unsigned char*)mixed + row * DM + mcol + v0) = pk4_fp8(res[0], res[1], res[2], res[3]); }
#else
                    u32x2 o; o.x = pk2(res[0], res[1]); o.y = pk2(res[2], res[3]); *(u32x2*)(orow + v0) = o; }
#endif
        }
    }
#undef GLA_LOAD_V
    __syncthreads();
    TP_END(27);
}

DI float expert_transpose_sum(const float (&pe)[32], int lane) {
    float p16[16], p8[8], p4[4], p2[2];
#pragma unroll
    for (int i = 0; i < 16; ++i) p16[i] = swap32_sum(pe[i], pe[i + 16]);
#pragma unroll
    for (int i = 0; i < 8; ++i) p8[i] = swap16_sum(p16[i], p16[i + 8]);
    { const bool up = (lane & 8) != 0;
#pragma unroll
      for (int i = 0; i < 4; ++i) { const float send = up ? p8[i] : p8[i + 4], keep = up ? p8[i + 4] : p8[i]; p4[i] = keep + dppf<0x128>(send); } }
    { const bool up = (lane & 4) != 0;
#pragma unroll
      for (int i = 0; i < 2; ++i) { const float send = up ? p4[i] : p4[i + 2], keep = up ? p4[i + 2] : p4[i]; p2[i] = keep + dppf<0x1B>(dppf<0x141>(send)); } }
    float p1;
    { const bool up = (lane & 2) != 0; const float send = up ? p2[0] : p2[1], keep = up ? p2[1] : p2[0]; p1 = keep + dppf<0x4E>(send); }
    p1 += dppf<0xB1>(p1);
    return p1;
}
NI void ph_p4(LAS unsigned char* lds_, unsigned char* ws_, const float* wr_, const float* br_, const float* lng_, const float* lnb_, int L_, int G_, int blk_, unsigned long long& tp_t0, unsigned long long& tp_acc) {
    Ctx X = make_ctx(lds_, uni(ws_), rfl(G_), rfl(blk_)); const int L = rfl(L_);
    const float* const wr = uni(wr_); const float* const brp = uni(br_); const float* const lngp = uni(lng_); const float* const lnbp = uni(lnb_);
    unsigned char* ws = X.ws; LAS unsigned char* lds = X.lds;
    LAS float* wrT = (LAS float*)lds;
    LAS int* sel_e = (LAS int*)(lds + 131072 + 1024); LAS float* sel_g = (LAS float*)(lds + 131072 + 1024 + 2048);
    LAS unsigned* hist = (LAS unsigned*)(lds + 131072 + 1024 + 4096); LAS unsigned* base = hist + 32;
    LAS float* wsc = (LAS float*)(lds + 131072 + 6144) + X.wave * 128;
    TP_BEGIN(50);
    { const int e = X.tid & 31, kg = X.tid >> 5;
      for (int m = 0; m < 16; ++m) { const int k0 = kg * 64 + 4 * m; f32x4 w4;
          w4[0] = wr[(k0 + 0) * 32 + e]; w4[1] = wr[(k0 + 1) * 32 + e]; w4[2] = wr[(k0 + 2) * 32 + e]; w4[3] = wr[(k0 + 3) * 32 + e];
          *(LAS f32x4*)(wrT + e * 1024 + k0) = w4; } }
    LAS float* lnL = (LAS float*)(lds + 131072 + 12288);
    if (X.tid < 256) { const f32x4 g4 = *(const f32x4*)(lngp + 4 * X.tid), b4 = *(const f32x4*)(lnbp + 4 * X.tid);
        *(LAS f32x4*)(lnL + 4 * X.tid) = g4; *(LAS f32x4*)(lnL + 1024 + 4 * X.tid) = b4; }
    const float* Y1 = (const float*)(ws + WS_Y1); float* X1 = (float*)(ws + WS_X1); bf16_t* X1B = (bf16_t*)(ws + WS_X1B); unsigned char* X1F8 = ws + WS_X1F8;
#if BF16_RESID && !Y1_F32
#define P4_LDY(row_, j_) ({ const u32x2 y2_ = *(const u32x2*)((const bf16_t*)Y1 + (size_t)(row_) * DM + 4 * lane + 256 * (j_)); (f32x4){bflo(y2_.x), bfhi(y2_.x), bflo(y2_.y), bfhi(y2_.y)}; })
#else
#define P4_LDY(row_, j_) (*(const f32x4*)(Y1 + (size_t)(row_) * DM + 4 * lane + 256 * (j_)))
#endif
    int* list = (int*)(ws + WS_LIST); int* asg = (int*)(ws + WS_ASG); float* gate = (float*)(ws + WS_GATE);
    unsigned* cnt = X.ctl + CW_CNT + L * NEXP;
    const int lane = X.lane;
    __syncthreads();
    TP_END(50);
    for (int grp = X.blk; grp < NTOK / 128; grp += X.G) {
        TP_BEGIN(51);
        if (X.tid < 32) hist[X.tid] = 0u;
        const size_t row0 = (size_t)grp * 128 + X.wave * 16;
#if BF16_RESID && !Y1_F32
#define P4_RAW 1
        u32x2 nv[2][4];
#define P4_LDRAW(row_, j_) (*(const u32x2*)((const bf16_t*)Y1 + (size_t)(row_) * DM + 4 * lane + 256 * (j_)))
#pragma unroll
        for (int q = 0; q < 2; ++q)
#pragma unroll
            for (int j = 0; j < 4; ++j) nv[q][j] = P4_LDRAW(row0 + q, j);
#else
#define P4_RAW 0
        f32x4 nv[2][4];
#pragma unroll
        for (int q = 0; q < 2; ++q)
#pragma unroll
            for (int j = 0; j < 4; ++j) nv[q][j] = P4_LDY(row0 + q, j);
#endif
        float brv[8];
#pragma unroll
        for (int g = 0; g < 8; ++g) brv[g] = brp[4 * g + 2 * (lane >> 5) + ((lane >> 4) & 1)];
#pragma unroll 1
        for (int it = 0; it < 8; ++it) {
            f32x4 v[2][4];
#if P4_RAW
#pragma unroll
            for (int q = 0; q < 2; ++q)
#pragma unroll
                for (int j = 0; j < 4; ++j) v[q][j] = (f32x4){bflo(nv[q][j].x), bfhi(nv[q][j].x), bflo(nv[q][j].y), bfhi(nv[q][j].y)};
            if (it + 1 < 8) {
#pragma unroll
                for (int q = 0; q < 2; ++q)
#pragma unroll
                    for (int j = 0; j < 4; ++j) nv[q][j] = P4_LDRAW(row0 + 2 * (it + 1) + q, j);
            }
#else
#pragma unroll
            for (int q = 0; q < 2; ++q)
#pragma unroll
                for (int j = 0; j < 4; ++j) v[q][j] = nv[q][j];
#endif
#pragma unroll
            for (int q = 0; q < 2; ++q) { const size_t row = row0 + 2 * it + q;
                float s = 0.f;
#pragma unroll
                for (int j = 0; j < 4; ++j) s += (v[q][j][0] + v[q][j][1]) + (v[q][j][2] + v[q][j][3]);
                const float mean = wave_allsum(s) * (1.f / DM); float s2 = 0.f;
#pragma unroll
                for (int j = 0; j < 4; ++j) { v[q][j] = v[q][j] - mean; s2 += (v[q][j][0] * v[q][j][0] + v[q][j][1] * v[q][j][1]) + (v[q][j][2] * v[q][j][2] + v[q][j][3] * v[q][j][3]); }
                const float rstd = __builtin_amdgcn_rsqf(wave_allsum(s2) * (1.f / DM) + LN_EPS);
#pragma unroll
                for (int j = 0; j < 4; ++j) { const f32x4 lgj = *(const LAS f32x4*)(lnL + 4 * lane + 256 * j), lbj = *(const LAS f32x4*)(lnL + 1024 + 4 * lane + 256 * j);
                    v[q][j] = v[q][j] * rstd * lgj + lbj;
#if !BF16_RESID
                    *(f32x4*)(X1 + row * DM + 4 * lane + 256 * j) = v[q][j];
#endif
#if !(F8_MOE && F8_PG) || BF16_RESID
                    { u32x2 o; o.x = pk2(v[q][j][0], v[q][j][1]); o.y = pk2(v[q][j][2], v[q][j][3]); *(u32x2*)(X1B + row * DM + 4 * lane + 256 * j) = o; }
#endif
#if F8_MOE
                    *(unsigned*)(X1F8 + row * DM + 4 * lane + 256 * j) = pk4_fp8(v[q][j][0], v[q][j][1], v[q][j][2], v[q][j][3]);
#endif
                }
            }
#if !P4_RAW
            if (it + 1 < 8) {
#pragma unroll
                for (int j = 0; j < 4; ++j) nv[0][j] = P4_LDY(row0 + 2 * (it + 1), j);
            }
#endif
            float resA[8], resB[8];
            f32x4 wA[2][4], wB[2][4];
#define P4_RD2(dst_, e0_) do { _Pragma("unroll") for (int ee_ = 0; ee_ < 2; ++ee_) _Pragma("unroll") for (int j_ = 0; j_ < 4; ++j_) dst_[ee_][j_] = *(const LAS f32x4*)(wrT + ((e0_) + ee_) * 1024 + 4 * lane + 256 * j_); } while (0)
#define P4_DOT2(src_, o_) do { _Pragma("unroll") for (int ee_ = 0; ee_ < 2; ++ee_) { f32x2 a_ = {0.f, 0.f}, b_ = {0.f, 0.f}; \
                _Pragma("unroll") for (int j_ = 0; j_ < 4; ++j_) { const f32x2 w0_ = {src_[ee_][j_][0], src_[ee_][j_][1]}, w1_ = {src_[ee_][j_][2], src_[ee_][j_][3]}; \
                    a_ = a_ + (f32x2){v[0][j_][0], v[0][j_][1]} * w0_; a_ = a_ + (f32x2){v[0][j_][2], v[0][j_][3]} * w1_; \
                    b_ = b_ + (f32x2){v[1][j_][0], v[1][j_][1]} * w0_; b_ = b_ + (f32x2){v[1][j_][2], v[1][j_][3]} * w1_; } \
                pa[(o_) + ee_] = a_[0] + a_[1]; pb[(o_) + ee_] = b_[0] + b_[1]; } } while (0)
#pragma unroll
            for (int g = 0; g < 8; ++g) { float pa[4], pb[4];
                if (g == 0) { P4_RD2(wA, 0); }
                P4_RD2(wB, 4 * g + 2); __builtin_amdgcn_sched_barrier(0);
                P4_DOT2(wA, 0);
                if (g < 7) { P4_RD2(wA, 4 * g + 4); } __builtin_amdgcn_sched_barrier(0);
                P4_DOT2(wB, 2);
                float ta = swap16_sum(swap32_sum(pa[0], pa[2]), swap32_sum(pa[1], pa[3])), tb = swap16_sum(swap32_sum(pb[0], pb[2]), swap32_sum(pb[1], pb[3]));
                ta += dppf<0xB1>(ta); tb += dppf<0xB1>(tb); ta += dppf<0x4E>(ta); tb += dppf<0x4E>(tb); ta += dppf<0x141>(ta); tb += dppf<0x141>(tb); ta += dppf<0x140>(ta); tb += dppf<0x140>(tb);
                resA[g] = ta; resB[g] = tb; }
#if !P4_RAW
            if (it + 1 < 8) {
#pragma unroll
                for (int j = 0; j < 4; ++j) nv[1][j] = P4_LDY(row0 + 2 * (it + 1) + 1, j);
            }
#endif
            if ((lane & 15) == 0) { const int eo = 2 * (lane >> 5) + ((lane >> 4) & 1);
#pragma unroll
                for (int g = 0; g < 8; ++g) { const float bb = brv[g]; wsc[4 * g + eo] = resA[g] + bb; wsc[32 + 4 * g + eo] = resB[g] + bb; } }
            const int me = lane >> 1, rq = lane & 1;
            const float myv = wsc[rq * 32 + me]; int rank = 0;
#pragma unroll
            for (int e4 = 0; e4 < 8; ++e4) { const f32x4 o = *(const LAS f32x4*)(wsc + rq * 32 + 4 * e4);
#pragma unroll
                for (int i = 0; i < 4; ++i) { const int oe = 4 * e4 + i; rank += ((o[i] > myv) || (o[i] == myv && oe < me)) ? 1 : 0; } }
            if (rank < 4) { ((LAS int*)wsc)[64 + rq * 4 + rank] = me; wsc[72 + rq * 4 + rank] = myv; }
            if (lane < 8) { const int q = lane >> 2, k = lane & 3;
                const f32x4 tv = *(const LAS f32x4*)(wsc + 72 + q * 4); const int mye = ((const LAS int*)wsc)[64 + q * 4 + k];
                const float e0 = 1.0f, e1 = __expf(tv[1] - tv[0]), e2 = __expf(tv[2] - tv[0]), e3 = __expf(tv[3] - tv[0]); const float rs = 1.0f / (e0 + e1 + e2 + e3);
                const float mine = (k == 0 ? e0 : k == 1 ? e1 : k == 2 ? e2 : e3) * rs;
                const int rloc = X.wave * 16 + 2 * it + q; sel_e[rloc * 4 + k] = mye; sel_g[rloc * 4 + k] = mine; }
        }
        __syncthreads();
        TP_END(51); TP_BEGIN(52);
        const int e = sel_e[X.tid]; const float g = sel_g[X.tid];
        const unsigned rank = __hip_atomic_fetch_add(hist + e, 1u, __ATOMIC_RELAXED, __HIP_MEMORY_SCOPE_WORKGROUP);
        __syncthreads();
        if (X.tid < 32) base[X.tid] = __hip_atomic_fetch_add(cnt + X.tid, hist[X.tid], RLX_AGENT);
        __syncthreads();
        const unsigned pos = base[e] + rank; const int tok = grp * 128 + (X.tid >> 2);
        list[(size_t)e * NTOK + pos] = tok; asg[(size_t)tok * 4 + (X.tid & 3)] = (e << 16) | (int)pos; gate[(size_t)tok * 4 + (X.tid & 3)] = g;
        __syncthreads();
        TP_END(52);
    }
}

DI void load_pfx(Ctx& X, int L) {
    __syncthreads();
    if (X.tid == 0) { int acc = 0; const unsigned* cnt = X.ctl + CW_CNT + L * NEXP;
        for (int e = 0; e < NEXP; ++e) { const int c = (int)cnt[e]; X.MISC[MW_PFX + e] = (unsigned)acc; X.MISC[MW_CNT + e] = (unsigned)c; acc += (c + 255) >> 8; }
        X.MISC[MW_PFX + NEXP] = (unsigned)acc; }
    __syncthreads();
}

NI void ph_p7(LAS unsigned char* lds_, unsigned char* ws_, const float* lng_, const float* lnb_, float* xout_, int L_, int G_, int blk_) {
    Ctx X = make_ctx(lds_, uni(ws_), rfl(G_), rfl(blk_)); const int L = rfl(L_);
    const float* const lngp = uni(lng_); const float* const lnbp = uni(lnb_); float* const xout = uni(xout_);
    load_pfx(X, L);
    unsigned char* ws = X.ws;
    const float* X1 = (const float*)(ws + WS_X1); const bf16_t* EP = (const bf16_t*)(ws + WS_EP); const bf16_t* YB = (const bf16_t*)(ws + WS_YB);
    const int* asg = (const int*)(ws + WS_ASG); const float* gate = (const float*)(ws + WS_GATE); bf16_t* XB = (bf16_t*)(ws + WS_XB);
    const int lane = X.lane;
    f32x4 lg[4], lb[4];
#pragma unroll
    for (int j = 0; j < 4; ++j) { lg[j] = *(const f32x4*)(lngp + 4 * lane + 256 * j); lb[j] = *(const f32x4*)(lnbp + 4 * lane + 256 * j); }
    const int shard = (X.blk >> 2) & 63, NSH = X.G >= 256 ? 64 : 1;
    unsigned* const ctr = X.ctl + 32768 + 64 * (64 * L + (NSH == 64 ? shard : 0));
#define P7_GRAB() __builtin_amdgcn_readfirstlane(lane == 0 ? (int)__hip_atomic_fetch_add(ctr, 1u, RLX_AGENT) : 0)
    const int NPAIR = (NTOK / 2) / NSH, pbase = (NSH == 64 ? shard : 0) * NPAIR;
    int pc = P7_GRAB(), pn = P7_GRAB();
    int na[2][4]; f32x4 ng[2];
#pragma unroll
    for (int q = 0; q < 2; ++q) { const int rr = pc < NPAIR ? 2 * (pbase + pc) + q : 0; const u32x4 a4 = *(const u32x4*)(asg + (size_t)rr * 4); na[q][0] = (int)a4.x; na[q][1] = (int)a4.y; na[q][2] = (int)a4.z; na[q][3] = (int)a4.w; ng[q] = *(const f32x4*)(gate + (size_t)rr * 4); }
    while (pc < NPAIR) {
        const int row = 2 * (pbase + pc);
        f32x4 x1v[2][4]; u32x2 epv[2][4], yv[2][4][4]; f32x4 gk[2];
#pragma unroll
        for (int q = 0; q < 2; ++q) { const int rr = row + q; gk[q] = ng[q];
#pragma unroll
            for (int k = 0; k < 4; ++k) { const int a = na[q][k]; const int e = a >> 16, pos = a & 0xffff; const size_t slot = (size_t)X.MISC[MW_PFX + e] * 256 + pos;
#if YB_F8 && F8_MOE
                const unsigned char* yr = (const unsigned char*)YB + slot * DM;
#pragma unroll
                for (int j = 0; j < 4; ++j) { yv[q][k][j].x = *(const unsigned*)(yr + 4 * lane + 256 * j); yv[q][k][j].y = 0u; } }
#else
                const bf16_t* yr = YB + slot * DM;
#pragma unroll
                for (int j = 0; j < 4; ++j) yv[q][k][j] = *(const u32x2*)(yr + 4 * lane + 256 * j); }
#endif
#pragma unroll
            for (int j = 0; j < 4; ++j) {
#if BF16_RESID
                { const u32x2 x2_ = *(const u32x2*)((const bf16_t*)(ws + WS_X1B) + (size_t)rr * DM + 4 * lane + 256 * j); x1v[q][j] = (f32x4){bflo(x2_.x), bfhi(x2_.x), bflo(x2_.y), bfhi(x2_.y)}; }
#else
                x1v[q][j] = *(const f32x4*)(X1 + (size_t)rr * DM + 4 * lane + 256 * j);
#endif
#if EP_F8
                epv[q][j].x = *(const unsigned*)((const unsigned char*)EP + (size_t)rr * DM + 4 * lane + 256 * j); epv[q][j].y = 0u; } }
#else
                epv[q][j] = *(const u32x2*)(EP + (size_t)rr * DM + 4 * lane + 256 * j); } }
#endif
        const int pnn = P7_GRAB();
#pragma unroll
        for (int q = 0; q < 2; ++q) { const int rr = pn < NPAIR ? 2 * (pbase + pn) + q : 0; const u32x4 a4 = *(const u32x4*)(asg + (size_t)rr * 4); na[q][0] = (int)a4.x; na[q][1] = (int)a4.y; na[q][2] = (int)a4.z; na[q][3] = (int)a4.w; ng[q] = *(const f32x4*)(gate + (size_t)rr * 4); }
#pragma unroll
        for (int q = 0; q < 2; ++q) { const int rw = row + q;
            f32x4 v[4];
#pragma unroll
#if EP_F8
            for (int j = 0; j < 4; ++j) { const f32x2 elo_ = __builtin_amdgcn_cvt_pk_f32_fp8((int)epv[q][j].x, false), ehi_ = __builtin_amdgcn_cvt_pk_f32_fp8((int)epv[q][j].x, true);
                v[j] = x1v[q][j] * DN_ALPHA + (f32x4){elo_[0], elo_[1], ehi_[0], ehi_[1]} * (1.0f / 16.0f);
#else
            for (int j = 0; j < 4; ++j) { v[j] = x1v[q][j] * DN_ALPHA + (f32x4){bflo(epv[q][j].x), bfhi(epv[q][j].x), bflo(epv[q][j].y), bfhi(epv[q][j].y)};
#endif
#pragma unroll
                for (int k = 0; k < 4; ++k) { const u32x2 y = yv[q][k][j];
#if YB_F8 && F8_MOE
                    const f32x2 ylo = __builtin_amdgcn_cvt_pk_f32_fp8((int)y.x, false), yhi = __builtin_amdgcn_cvt_pk_f32_fp8((int)y.x, true);
                    v[j] = v[j] + (f32x4){ylo[0], ylo[1], yhi[0], yhi[1]} * gk[q][k]; } }
#else
                    v[j] = v[j] + (f32x4){bflo(y.x), bfhi(y.x), bflo(y.y), bfhi(y.y)} * gk[q][k]; } }
#endif
            float s_ = 0.f;
#pragma unroll
            for (int j = 0; j < 4; ++j) s_ += (v[j][0] + v[j][1]) + (v[j][2] + v[j][3]);
            const float mean = wave_allsum(s_) * (1.f / DM); float s2 = 0.f;
#pragma unroll
            for (int j = 0; j < 4; ++j) { v[j] = v[j] - mean; s2 += (v[j][0] * v[j][0] + v[j][1] * v[j][1]) + (v[j][2] * v[j][2] + v[j][3] * v[j][3]); }
            const float rstd = __builtin_amdgcn_rsqf(wave_allsum(s2) * (1.f / DM) + LN_EPS);
#pragma unroll
            for (int j = 0; j < 4; ++j) { v[j] = v[j] * rstd * lg[j] + lb[j]; if (!BF16_RESID || L == DEPTH - 1) *(f32x4*)(xout + (size_t)rw * DM + 4 * lane + 256 * j) = v[j];
#if F8_IN
                *(unsigned*)((unsigned char*)XB + (size_t)rw * DM + 4 * lane + 256 * j) = pk4_fp8(v[j][0], v[j][1], v[j][2], v[j][3]); } }
#else
                if (L + 1 < DEPTH) { u32x2 o; o.x = pk2(v[j][0], v[j][1]); o.y = pk2(v[j][2], v[j][3]); *(u32x2*)(XB + (size_t)rw * DM + 4 * lane + 256 * j) = o; } } }
#endif
        pc = pn; pn = pnn;
    }
#undef P7_GRAB
}

NI void ph_gemm_in(LAS unsigned char* lds, const void* A_, const void* B_, bf16_t* O_, int G_, int blk_) {
    pg8::StaticOrder S; S.init(NTOK, ZW, rfl(G_), rfl(blk_));
    pg8::EpiBf16 E{uni(O_), ZW, nullptr, 0, F8_IN ? 1.0f / 32.0f : 1.0f};
    pg8::gemm_phase<pg8::EpiBf16, pg8::StaticOrder, pg8::NoGather, true, F8_IN != 0>(lds, uni(A_), uni(B_), DM, S, E, pg8::NoGather{});
}
NI void ph_gemm_out(LAS unsigned char* lds, const void* A_, const void* B_, const void* X_, void* Y_, int G_, int blk_) {
    pg8::StaticOrder S; S.init(NTOK, DM, rfl(G_), rfl(blk_));
#if BF16_RESID && Y1_F32
    pg8::EpiResidXB E{(const bf16_t*)uni(X_), (float*)uni(Y_), DN_ALPHA, F8_OUT ? 1.0f / 32.0f : 1.0f};
    pg8::gemm_phase<pg8::EpiResidXB, pg8::StaticOrder, pg8::NoGather, true, F8_OUT != 0>(lds, uni(A_), uni(B_), DM, S, E, pg8::NoGather{});
#elif BF16_RESID
    pg8::EpiResidB E{(const bf16_t*)uni(X_), (bf16_t*)uni(Y_), DN_ALPHA, F8_OUT ? 1.0f / 32.0f : 1.0f};
    pg8::gemm_phase<pg8::EpiResidB, pg8::StaticOrder, pg8::NoGather, true, F8_OUT != 0>(lds, uni(A_), uni(B_), DM, S, E, pg8::NoGather{});
#else
    pg8::EpiResid E{(const float*)uni(X_), (float*)uni(Y_), DN_ALPHA, F8_OUT ? 1.0f / 32.0f : 1.0f};
    pg8::gemm_phase<pg8::EpiResid, pg8::StaticOrder, pg8::NoGather, true, F8_OUT != 0>(lds, uni(A_), uni(B_), DM, S, E, pg8::NoGather{});
#endif
}
NI void ph_gemm_pp(LAS unsigned char* lds, const bf16_t* A_, const bf16_t* B_, bf16_t* O_, int G_, int blk_) {
    pg8::StaticOrder S; S.init(NTOK, DM, rfl(G_), rfl(blk_));
#if PP_F8 && EP_F8
    pg8::EpiBf16T<true> E{uni(O_), DM, nullptr, 0, 16.0f};
    pg8::gemm_phase<pg8::EpiBf16T<true>, pg8::StaticOrder, pg8::NoGather, true>(lds, uni(A_), uni(B_), PLE, S, E, pg8::NoGather{});
#else
    pg8::EpiBf16 E{uni(O_), DM, nullptr, 0, 1.0f};
    pg8::gemm_phase<pg8::EpiBf16, pg8::StaticOrder, pg8::NoGather, true>(lds, uni(A_), uni(B_), PLE, S, E, pg8::NoGather{});
#endif
}
NI void ph_gemm_gu(LAS unsigned char* lds, unsigned char* ws_, const void* A_, const void* B_, void* O_, const float* bias_, const int* list_, int L_, int G_, int blk_) {
    Ctx X = make_ctx(lds, uni(ws_), rfl(G_), rfl(blk_)); load_pfx(X, rfl(L_));
    pg8::MoeOrder S; S.init((const LAS int*)(lds + MISC_OFF) + MW_PFX, (const LAS int*)(lds + MISC_OFF) + MW_CNT, 8, X.G, X.blk, (LAS int*)(lds + MISC_OFF + 30720));
    pg8::MoeGather Gt{uni(list_)};
#if F8_MOE
    pg8::EpiSwiglu<true> E{uni(O_), uni(bias_), 1.0f / 32.0f};
    pg8::gemm_phase<pg8::EpiSwiglu<true>, pg8::MoeOrder, pg8::MoeGather, true, true>(lds, uni(A_), uni(B_), DM, S, E, Gt);
#else
    pg8::EpiSwiglu<false> E{uni(O_), uni(bias_), 1.0f};
    pg8::gemm_phase<pg8::EpiSwiglu<false>, pg8::MoeOrder, pg8::MoeGather, true, false>(lds, uni(A_), uni(B_), DM, S, E, Gt);
#endif
}
NI void ph_gemm_pg(LAS unsigned char* lds, const void* A_, const void* B_, bf16_t* O_, const bf16_t* PP_, const float* bias_, int G_, int blk_) {
    pg8::StaticOrder S; S.init(NTOK, DM, rfl(G_), rfl(blk_));
    pg8::EpiPle E{uni(O_), uni(PP_), uni(bias_), F8_PG ? 1.0f / 32.0f : 1.0f};
    pg8::gemm_phase<pg8::EpiPle, pg8::StaticOrder, pg8::NoGather, true, F8_PG != 0>(lds, uni(A_), uni(B_), DM, S, E, pg8::NoGather{});
}
NI void ph_gemm_dn(LAS unsigned char* lds, unsigned char* ws_, const void* A_, const void* B_, bf16_t* O_, const float* bias_, int L_, int G_, int blk_) {
    Ctx X = make_ctx(lds, uni(ws_), rfl(G_), rfl(blk_)); load_pfx(X, rfl(L_));
    pg8::MoeOrder S; S.init((const LAS int*)(lds + MISC_OFF) + MW_PFX, (const LAS int*)(lds + MISC_OFF) + MW_CNT, 4, X.G, X.blk, (LAS int*)(lds + MISC_OFF + 30720));
#if F8_MOE
    pg8::EpiBf16T<YB_F8 != 0> E{uni(O_), DM, uni(bias_), DM, 1.0f / 32.0f};
    pg8::gemm_phase<pg8::EpiBf16T<YB_F8 != 0>, pg8::MoeOrder, pg8::NoGather, true, true>(lds, uni(A_), uni(B_), DFF, S, E, pg8::NoGather{});
#else
    pg8::EpiBf16 E{uni(O_), DM, uni(bias_), DM, 1.0f};
    pg8::gemm_phase<pg8::EpiBf16, pg8::MoeOrder, pg8::NoGather, true, false>(lds, uni(A_), uni(B_), DFF, S, E, pg8::NoGather{});
#endif
}
NI void ph_p2(LAS unsigned char* lds, unsigned char* ws_, const float* relb_, const float* dlam_, const float* dnorm_, const float* wg_, const float* bg_, const float* gng_, const float* w_gu_, const float* w_dn_, int L_, int qi_, int G_, int blk_, unsigned long long& tp_t0, unsigned long long& tp_acc) {
    Ctx X = make_ctx(lds, uni(ws_), rfl(G_), rfl(blk_)); const int L = rfl(L_); unsigned char* const ws = X.ws;
    const float* const relb = uni(relb_); const float* const dl = uni(dlam_); const float* const dnorm = uni(dnorm_);
    const float lam_init = L == 0 ? 0.20000000000000007f : L == 1 ? 0.35550906759096934f : L == 2 ? 0.4707130183435842f : 0.5560582041556406f;
    { const int hq = X.tid >> 7, n = X.tid & 127; int bk;
      if (n < 16) bk = n; else { bk = 16 + (int)(__logf((float)n * (1.0f / 16.0f)) / __logf(8.0f) * 16.0f); bk = bk > 31 ? 31 : bk; }
      ((LAS float*)(lds + AT_BIAS_OFF))[hq * 128 + n] = relb[bk * 4 + hq] * LOG2E; }
    if (X.wave == 0) { const float s1 = wave_allsum(dl[X.lane] * dl[64 + X.lane]), s2 = wave_allsum(dl[128 + X.lane] * dl[192 + X.lane]);
        if (X.lane == 0) ((LAS float*)(lds + AT_BIAS_OFF))[512] = __expf(s1) - __expf(s2) + lam_init; }
    __syncthreads();
#ifndef NO_GLA
    TP_BEGIN(22); TP_BEGIN(23); TP_BEGIN(20);
    for (int rep2 = 0; rep2 < ((DUP_MASK >> 8) & 1) + 1; ++rep2)
    for (int s = X.blk; s < 32; s += X.G) gla_stream3(lds, ws, wg_, bg_, gng_, s, s >> 2, s & 3, tp_t0, tp_acc);
    TP_END(20); TP_BEGIN(21);
#endif
#ifndef NO_RET
    for (int rep2 = 0; rep2 < ((DUP_MASK >> 9) & 1) + 1; ++rep2)
    for (int s = (X.blk + X.G - (32 % X.G)) % X.G; s < 32; s += X.G) stream_run<128, 64, false>(lds, ws, wg_, bg_, gng_, 32 + s, s >> 2, s & 3);
#endif
    TP_END(21);
#ifndef NO_ATT
    for (int rep2 = 0; rep2 < ((DUP_MASK >> 10) & 1) + 1; ++rep2) {
    unsigned* qhead = X.ctl + CW_Q + 64 * (rfl(qi_) + 8 * rep2);
#if F8_MOE && MOE_CVT_P2
    const int nskip = X.G > 64 ? 32 : 0;
    int nun = 0, cvt_at = X.blk < nskip ? -1 : (X.blk < 64 ? 0 : X.blk % 3); bool qdone = false;
#endif
    for (;;) {
#if F8_MOE && MOE_CVT_P2
        if (nun == cvt_at) { Ctx Xc = X; const int t_ = opaque_tid(); Xc.lane = t_ & 63; Xc.wave = rfl(t_ >> 6);
            LAS float* scr = (LAS float*)(lds + Xc.wave * 12288); const int gw = (X.blk - nskip) * 8 + Xc.wave, NGW = (X.G - nskip) * 8;
            transpose_batch_f8(Xc, uni(w_gu_) + (size_t)L * NEXP * DM * 2 * DFF, ws + WS_WGU + (size_t)L * NEXP * 2048 * DM, NEXP, DM, 2 * DFF, 32.0f, gw, NGW, scr);
            transpose_batch_f8(Xc, uni(w_dn_) + (size_t)L * NEXP * DFF * DM, ws + WS_WDN + (size_t)L * NEXP * DM * DFF, NEXP, DFF, DM, 32.0f, gw, NGW, scr);
            cvt_at = -1; }
        if (qdone) break;
#endif
        if (opaque_tid() == 0) X.MISC[MW_Q] = __hip_atomic_fetch_add(qhead, 1u, RLX_AGENT);
        __syncthreads();
        const int u = rfl((int)X.MISC[MW_Q]);
        __syncthreads();
#if F8_MOE && MOE_CVT_P2
        if (u >= 1024) { if (cvt_at < 0) break; cvt_at = nun; qdone = true; continue; }
        ++nun;
#else
        if (u >= 1024) break;
#endif
        const int qb = 31 - (u >> 5), bh = u & 31;
        const float lam_u = ((const LAS float*)(lds + AT_BIAS_OFF))[512];
        attn_unit(lds, (const bf16_t*)(ws + WS_Z), (bf16_t*)(ws + WS_MIX), bh >> 2, bh & 3, qb, lam_u, 1.0f - lam_init, dnorm, tp_t0, tp_acc);
    }
    }
#endif
    TP_END(22); TP_END(23);
}

constexpr int NPH = 1 + DEPTH * 7;
__global__ void __launch_bounds__(512, 2) fwd_kernel(Args args) {
    extern __shared__ __attribute__((aligned(16))) unsigned char lds_raw[];
    LAS unsigned char* const lds = (LAS unsigned char*)lds_raw;
    volatile LAS unsigned* const MISC = (volatile LAS unsigned*)(lds + MISC_OFF);
    unsigned char* const ws = args.ws; unsigned* const ctl = (unsigned*)(ws + WS_CTL);
    const int G = gridDim.x, blk = blockIdx.x;
    for (int u = threadIdx.x; u < 1024; u += 512) ((LAS unsigned*)(lds + MISC_OFF))[u] = 0u;
    __syncthreads();
#if MK_SPLIT
#define GRID_BAR() do { } while (0)
#else
    XcdBarrier bar = xcd_barrier_post(ctl + CW_BAR, MISC + MW_BAR);
#define GRID_BAR() xcd_barrier(bar)
#endif
    unsigned long long tp_t0 = 0ull, tp_acc = 0ull;
    TP_BEGIN(30);
    const int lo = args.ph_lo, hi = args.ph_hi;
#define IN(k) (lo <= (k) && (k) < hi)
#define SEAM(k) do { if (IN((k) + 1)) GRID_BAR(); } while (0)
#define SPREAD_MARK(ph) do { if (PROBE_ID >= 100 && threadIdx.x == 0) __hip_atomic_store(ctl + 16384 + ((L * 8 + (ph)) << 8) + blockIdx.x, (unsigned)__builtin_amdgcn_s_memrealtime(), RLX_AGENT); } while (0)
#define SPREAD_READ(ph) do { } while (0)
    bf16_t* const XB = (bf16_t*)(ws + WS_XB); bf16_t* const Zb = (bf16_t*)(ws + WS_Z); bf16_t* const MIX = (bf16_t*)(ws + WS_MIX);
    float* const Y1 = (float*)(ws + WS_Y1); bf16_t* const X1B = (bf16_t*)(ws + WS_X1B); bf16_t* const PP = (bf16_t*)(ws + WS_PP); bf16_t* const EP = (bf16_t*)(ws + WS_EP);
    bf16_t* const ACT = (bf16_t*)(ws + WS_ACT); bf16_t* const YB = (bf16_t*)(ws + WS_YB);

#ifndef NO_P0
    if (IN(0)) { TP_BEGIN(0); for (int rep = 0; rep < ((DUP_MASK >> 0) & 1) + 1; ++rep) ph_p0(lds, ws, args.in[0], args.in[1], args.in[2], args.in[8], args.in[14], args.in[16], args.in[18], args.in[20], G, blk); SEAM(0); TP_END(0); }
#endif
    for (int L = 0; L < DEPTH; ++L) {
        const int pb = 1 + L * 7;
#ifndef NO_P1
        if (IN(pb + 0)) { TP_BEGIN(1); for (int rep = 0; rep < ((DUP_MASK >> 1) & 1) + 1; ++rep) ph_gemm_in(lds, XB, ws + WS_WIN + (size_t)L * ZW * DM * (F8_IN ? 1 : 2), Zb, G, blk); SPREAD_MARK(1); SEAM(pb + 0); SPREAD_READ(1); TP_END(1); }
#endif
#ifndef NO_P2
        if (IN(pb + 1)) { TP_BEGIN(2); for (int rep = 0; rep < ((DUP_MASK >> 2) & 1) + 1; ++rep) ph_p2(lds, ws, args.in[9], args.in[6] + (size_t)L * 256, args.in[7] + (size_t)L * 128, args.in[3] + (size_t)L * 16 * 128, args.in[4] + (size_t)L * 128, args.in[5] + (size_t)L * 64, args.in[14], args.in[16], L, L + 4 * rep, G, blk, tp_t0, tp_acc); SPREAD_MARK(2); SEAM(pb + 1); SPREAD_READ(2); TP_END(2); }
#endif
#ifndef NO_P3
        if (IN(pb + 2)) { TP_BEGIN(3); for (int rep = 0; rep < ((DUP_MASK >> 3) & 1) + 1; ++rep) {
            TP_BEGIN(32); ph_gemm_pp(lds, (const bf16_t*)(ws + WS_PB) + (size_t)L * NTOK * PLE, (const bf16_t*)(ws + WS_WPP) + (size_t)L * DM * PLE, PP, G, blk); TP_END(32);
            TP_BEGIN(31); ph_gemm_out(lds, MIX, ws + WS_WOUT + (size_t)L * DM * DM * (F8_OUT ? 1 : 2), BF16_RESID ? (const void*)XB : (L == 0 ? (const void*)args.in[0] : (const void*)args.out), Y1, G, blk); TP_END(31); }
            SPREAD_MARK(3); SEAM(pb + 2); SPREAD_READ(3); TP_END(3);
        }
#endif
#ifndef NO_P4
        if (IN(pb + 3)) { TP_BEGIN(4); for (int rep = 0; rep < ((DUP_MASK >> 4) & 1) + 1; ++rep) ph_p4(lds, ws, args.in[12] + (size_t)L * DM * NEXP, args.in[13] + (size_t)L * NEXP, args.in[10] + (size_t)L * DM, args.in[11] + (size_t)L * DM, L + 4 * rep, G, blk, tp_t0, tp_acc); SPREAD_MARK(4); SEAM(pb + 3); SPREAD_READ(4); TP_END(4); }
#endif
#ifndef NO_P5
        if (IN(pb + 4)) { TP_BEGIN(5); for (int rep = 0; rep < ((DUP_MASK >> 5) & 1) + 1; ++rep) {
#if F8_MOE
            ph_gemm_gu(lds, ws, ws + WS_X1F8, ws + WS_WGU + (size_t)L * NEXP * 2048 * DM, ACT, args.in[15] + (size_t)L * NEXP * 2048, (const int*)(ws + WS_LIST), L, G, blk);
#else
            ph_gemm_gu(lds, ws, X1B, (const bf16_t*)(ws + WS_WGU) + (size_t)L * NEXP * 2048 * DM, ACT, args.in[15] + (size_t)L * NEXP * 2048, (const int*)(ws + WS_LIST), L, G, blk);
#endif
            ph_gemm_pg(lds, F8_PG ? (const void*)(ws + WS_X1F8) : (const void*)X1B, ws + WS_WPG + (size_t)L * DM * DM * (F8_PG ? 1 : 2), EP, PP, args.in[19] + (size_t)L * DM, G, blk); }
            SPREAD_MARK(5); SEAM(pb + 4); SPREAD_READ(5); TP_END(5);
        }
#endif
#ifndef NO_P6
        if (IN(pb + 5)) { TP_BEGIN(6); for (int rep = 0; rep < ((DUP_MASK >> 6) & 1) + 1; ++rep) ph_gemm_dn(lds, ws, ACT, ws + WS_WDN + (size_t)L * NEXP * DM * DFF * (F8_MOE ? 1 : 2), YB, args.in[17] + (size_t)L * NEXP * DM, L, G, blk); SPREAD_MARK(6); SEAM(pb + 5); SPREAD_READ(6); TP_END(6); }
#endif
#ifndef NO_P7
        if (IN(pb + 6)) { TP_BEGIN(7); for (int rep = 0; rep < ((DUP_MASK >> 7) & 1) + 1; ++rep) ph_p7(lds, ws, args.in[21] + (size_t)L * DM, args.in[22] + (size_t)L * DM, args.out, L, G, blk); SPREAD_MARK(7); if (L + 1 < DEPTH) { SEAM(pb + 6); SPREAD_READ(7); } TP_END(7); }
#endif
    }
#undef IN
#undef SEAM
    TP_END(30);
    if ((PROBE_ID == 40 || PROBE_ID == 41) && blockIdx.x == 0 && threadIdx.x == 0) tp_acc = *(volatile LAS unsigned long long*)(lds + 131072 + 72 * 4);
    if (PROBE_ID >= 100 && blockIdx.x == 0 && threadIdx.x == 0) {
        for (int L = 0; L < 3; ++L) { unsigned mn = 0xffffffffu, mx = 0u;
            for (int q = 0; q < (int)gridDim.x; ++q) { const unsigned v = __hip_atomic_load(ctl + 16384 + ((L * 8 + (PROBE_ID - 100)) << 8) + q, RLX_AGENT); mn = v < mn ? v : mn; mx = v > mx ? v : mx; }
            if (PROBE_ID < 200) tp_acc += (unsigned long long)(mx - mn); } }
    if (PROBE_ID >= 200 && blockIdx.x == 0 && threadIdx.x == 0) {
        for (int L = 0; L < 3; ++L) { unsigned mx = 0u; unsigned long long sm = 0ull; unsigned v0 = __hip_atomic_load(ctl + 16384 + ((L * 8 + (PROBE_ID - 200)) << 8), RLX_AGENT);
            for (int q = 0; q < (int)gridDim.x; ++q) { const unsigned v = __hip_atomic_load(ctl + 16384 + ((L * 8 + (PROBE_ID - 200)) << 8) + q, RLX_AGENT) - v0 + 1000000u; mx = v > mx ? v : mx; sm += v; }
            tp_acc += (unsigned long long)mx - sm / gridDim.x; } }
    if (PROBE_ID >= 0 && blockIdx.x == PROBE_BLK && threadIdx.x == 0) { const unsigned long long tend = __builtin_amdgcn_s_memrealtime() + tp_acc; while (__builtin_amdgcn_s_memrealtime() < tend) __builtin_amdgcn_s_sleep(8); }
}

extern "C" void kernel_launch(void* const* d_in, const int* in_sizes, int n_in, void* d_out, int out_size, void* d_ws, size_t ws_size, hipStream_t stream) {
    static int grid = 0;
    if (grid == 0) {
        if (n_in != 23 || out_size != NTOK * DM || ws_size < WS_END) { fprintf(stderr, "kernel_launch: unexpected shapes (n_in %d, out %d, ws %zu < %zu)\n", n_in, out_size, ws_size, (size_t)WS_END); grid = -1; return; }
        int dev = 0, cus = 0, per_cu = 0;
        if (hipGetDevice(&dev) != hipSuccess || hipDeviceGetAttribute(&cus, hipDeviceAttributeMultiprocessorCount, dev) != hipSuccess) { grid = -1; return; }
        if (hipFuncSetAttribute((const void*)fwd_kernel, hipFuncAttributeMaxDynamicSharedMemorySize, LDS_BYTES) != hipSuccess) { fprintf(stderr, "kernel_launch: hipFuncSetAttribute failed\n"); grid = -1; return; }
        if (hipOccupancyMaxActiveBlocksPerMultiprocessor(&per_cu, (const void*)fwd_kernel, 512, LDS_BYTES) != hipSuccess || per_cu < 1) { fprintf(stderr, "kernel_launch: occupancy query says %d\n", per_cu); }
        (void)hipGetLastError();
        grid = cus;
    }
    if (grid < 0) return;
    (void)hipMemsetAsync((char*)d_ws + WS_CTL, 0, CTL_ZERO_BYTES, stream);
    Args a{};
    for (int i = 0; i < 23; ++i) a.in[i] = (const float*)d_in[i];
    a.out = (float*)d_out; a.ws = (unsigned char*)d_ws;
#if MK_SPLIT
    for (int p = 0; p < NPH; ++p) { a.ph_lo = p; a.ph_hi = p + 1; hipLaunchKernelGGL(fwd_kernel, dim3(grid), dim3(512), LDS_BYTES, stream, a); }
#else
    a.ph_lo = 0; a.ph_hi = NPH;
    hipLaunchKernelGGL(fwd_kernel, dim3(grid), dim3(512), LDS_BYTES, stream, a);
#endif
}
```
